# Optimizing an MI355X kernel written in HIP

```python
import jax, jax.numpy as jnp
from jax import lax
import numpy as np

D_MODEL = 1024
BATCH = 1
SEQ = 16384
DEPTH = 1
DEC_BATCH = 32
DEC_SEQ = 4
PAST_LEN = 16384
PAGE_SIZE = 128

N_HEADS = 8
HEAD_DIM = 64
ATTN_WIDTH = N_HEADS * HEAD_DIM
GMLP_GROUPS = 8
GMLP_WIDTH = 512
GMLP_GROUP_DIM = GMLP_WIDTH // GMLP_GROUPS
CHUNK = 128
DILATIONS = ((128, 1), (512, 4), (2048, 16))
WINDOW_MAX = 2048
BLOCK = 128
ROT_DIM = HEAD_DIM // 4
ROPE_THETA = 500000.0
D_FF = 4 * D_MODEL
PLE_DIM = 256
IN_WIDTH = 3 * ATTN_WIDTH + 2 * GMLP_WIDTH
EPS = 1e-6
NEG = -1e30

kernel_name = "hymba_dilated_gmlp_decoder_step"


def rmsnorm(x, g):
    xf = x.astype(jnp.float32)
    y = xf * lax.rsqrt(jnp.mean(xf * xf, axis=-1, keepdims=True) + EPS)
    return (y * g.astype(jnp.float32)).astype(x.dtype)


def layernorm(x, g, b):
    xf = x.astype(jnp.float32)
    mu = jnp.mean(xf, axis=-1, keepdims=True)
    var = jnp.mean(jnp.square(xf - mu), axis=-1, keepdims=True)
    y = (xf - mu) * lax.rsqrt(var + EPS)
    return (y * g.astype(jnp.float32) + b.astype(jnp.float32)).astype(x.dtype)


def rope_partial(x, pos):
    half = ROT_DIM // 2
    inv_freq = ROPE_THETA ** (-jnp.arange(0, ROT_DIM, 2, dtype=jnp.float32) / ROT_DIM)
    ang = pos.astype(jnp.float32)[:, None] * inv_freq[None, :]
    cos = jnp.cos(ang)[:, None, :].astype(x.dtype)
    sin = jnp.sin(ang)[:, None, :].astype(x.dtype)
    x1, x2, rest = x[..., :half], x[..., half:ROT_DIM], x[..., ROT_DIM:]
    return jnp.concatenate([x1 * cos - x2 * sin, x2 * cos + x1 * sin, rest], axis=-1)


def project(h, pos, norm_g, w_in):
    B, T, _ = h.shape
    z = rmsnorm(h, norm_g) @ w_in
    q, k, v, u, vc = jnp.split(z, np.cumsum([ATTN_WIDTH] * 3 + [GMLP_WIDTH]).tolist(), axis=-1)
    q = rope_partial(q.reshape(B, T, N_HEADS, HEAD_DIM), pos)
    k = rope_partial(k.reshape(B, T, N_HEADS, HEAD_DIM), pos)
    v = v.reshape(B, T, N_HEADS, HEAD_DIM)
    return q, k, v, jax.nn.gelu(u), jax.nn.gelu(vc)


def softmax_stats(s):
    m = jnp.max(s, axis=-1, keepdims=True)
    e = jnp.exp(s - m)
    den = jnp.sum(e, axis=-1, keepdims=True)
    return e / den, (m + jnp.log(den))[..., 0]


def dilated_attn_prompt(q, k, v, window, dil):
    B, S, H, D = q.shape
    span = window // dil
    n = S // dil
    nb = -(-n // BLOCK)
    pad = nb * BLOCK - n

    def sub(a):
        return a.reshape(B, n, dil, H, D).transpose(0, 2, 1, 3, 4)

    qs = jnp.pad(sub(q), ((0, 0), (0, 0), (0, pad), (0, 0), (0, 0))).reshape(B, dil, nb, BLOCK, H, D)

    def kwin(a):
        a = jnp.pad(sub(a), ((0, 0), (0, 0), (BLOCK, pad), (0, 0), (0, 0))).reshape(B, dil, nb + 1, BLOCK, H, D)
        return jnp.concatenate([a[:, :, :-1], a[:, :, 1:]], axis=3)

    ks, vs = kwin(k), kwin(v)
    s = jnp.einsum('brnqhd,brnkhd->brnhqk', qs, ks, preferred_element_type=jnp.float32) * (HEAD_DIM ** -0.5)
    qi = jnp.arange(BLOCK)[:, None]
    kj = jnp.arange(2 * BLOCK)[None, :]
    diff = qi + BLOCK - kj
    band = (diff >= 0) & (diff <= span)
    not_before_start = (jnp.arange(nb)[:, None, None] > 0) | (kj[None] >= BLOCK)
    mask = band[None] & not_before_start
    s = jnp.where(mask[:, None], s, NEG)
    p, lse = softmax_stats(s)
    o = jnp.einsum('brnhqk,brnkhd->brnqhd', p, vs.astype(jnp.float32))
    o = o.reshape(B, dil, nb * BLOCK, H, D)[:, :, :n].transpose(0, 2, 1, 3, 4).reshape(B, S, H, D)
    lse = lse.transpose(0, 1, 2, 4, 3).reshape(B, dil, nb * BLOCK, H)[:, :, :n]
    lse = lse.transpose(0, 2, 1, 3).reshape(B, S, H)
    return o, lse


def dilated_attn_sample(q, k_all, v_all, window, dil, lbuf):
    T = q.shape[1]
    span = window // dil
    idx = lbuf + jnp.arange(T)[:, None] - dil * jnp.arange(span + 1)[None, :]
    valid = idx >= 0
    idx = jnp.maximum(idx, 0)
    kg = k_all[:, idx]
    vg = v_all[:, idx]
    s = jnp.einsum('bthd,btkhd->bthk', q, kg, preferred_element_type=jnp.float32) * (HEAD_DIM ** -0.5)
    s = jnp.where(valid[None, :, None, :], s, NEG)
    p, lse = softmax_stats(s)
    o = jnp.einsum('bthk,btkhd->bthd', p, vg.astype(jnp.float32))
    return o, lse


def combine_dilations(outs, lses):
    w = jax.nn.softmax(jnp.stack(lses, axis=0), axis=0)
    return jnp.sum(w[..., None] * jnp.stack(outs, axis=0), axis=0)


def gmlp_gate(u, vc, ln_g, ln_b, w_s, b_s):
    B, T, _ = u.shape
    vn = layernorm(vc, ln_g, ln_b)
    L = min(T, CHUNK)
    n = T // L
    tril = jnp.tril(jnp.ones((L, L), dtype=bool))
    w = jnp.where(tril[None], w_s[:, :L, :L], 0).astype(vn.dtype)
    vg = vn.reshape(B, n, L, GMLP_GROUPS, GMLP_GROUP_DIM)
    mixed = jnp.einsum('gij,bnjgc->bnigc', w, vg) + b_s[:, :L].T[:, :, None]
    return u * mixed.reshape(B, T, GMLP_WIDTH), vn


def finish(h, attn, gated, p, w_out, norm2_g, w_up, w_down, gate_norm_g, w_gate, w_ple):
    B, T, _ = h.shape
    mix = jnp.concatenate([attn.reshape(B, T, ATTN_WIDTH).astype(h.dtype), gated], axis=-1)
    h = h + mix @ w_out
    f = jnp.square(jax.nn.relu(rmsnorm(h, norm2_g) @ w_up)) @ w_down
    h = h + f
    gate = jax.nn.sigmoid(rmsnorm(h, gate_norm_g) @ w_gate)
    return h + gate * (p @ w_ple)


def setup_inputs(seed: int = 0) -> dict:
    key = jax.random.key(seed)
    ks = jax.random.split(key, 24)
    f32 = jnp.float32
    nrm = lambda k, shape, scale: jax.random.normal(k, shape, f32) * scale
    wbuf = min(WINDOW_MAX, PAST_LEN)
    return {
        "x_prompt": nrm(ks[0], (BATCH, SEQ, D_MODEL), 1.0),
        "x_sample": nrm(ks[1], (DEC_BATCH, DEC_SEQ, D_MODEL), 1.0),
        "cache_k": nrm(ks[2], (DEPTH, DEC_BATCH, wbuf, N_HEADS, HEAD_DIM), 1.0),
        "cache_v": nrm(ks[3], (DEPTH, DEC_BATCH, wbuf, N_HEADS, HEAD_DIM), 1.0),
        "p_prompt": nrm(ks[4], (DEPTH, BATCH, SEQ, PLE_DIM), 1.0),
        "p_sample": nrm(ks[5], (DEPTH, DEC_BATCH, DEC_SEQ, PLE_DIM), 1.0),
        "norm1_g": 1.0 + nrm(ks[6], (DEPTH, D_MODEL), 0.02),
        "w_in": nrm(ks[7], (DEPTH, D_MODEL, IN_WIDTH), D_MODEL ** -0.5),
        "ln_v_g": 1.0 + nrm(ks[8], (DEPTH, GMLP_WIDTH), 0.02),
        "ln_v_b": nrm(ks[9], (DEPTH, GMLP_WIDTH), 0.02),
        "w_spatial": nrm(ks[10], (DEPTH, GMLP_GROUPS, CHUNK, CHUNK), CHUNK ** -0.5),
        "b_spatial": nrm(ks[11], (DEPTH, GMLP_GROUPS, CHUNK), 0.02),
        "w_out": nrm(ks[12], (DEPTH, ATTN_WIDTH + GMLP_WIDTH, D_MODEL), (ATTN_WIDTH + GMLP_WIDTH) ** -0.5),
        "norm2_g": 1.0 + nrm(ks[13], (DEPTH, D_MODEL), 0.02),
        "w_up": nrm(ks[14], (DEPTH, D_MODEL, D_FF), D_MODEL ** -0.5),
        "w_down": nrm(ks[15], (DEPTH, D_FF, D_MODEL), D_FF ** -0.5),
        "gate_norm_g": 1.0 + nrm(ks[16], (DEPTH, D_MODEL), 0.02),
        "w_gate": nrm(ks[17], (DEPTH, D_MODEL, D_MODEL), D_MODEL ** -0.5),
        "w_ple": nrm(ks[18], (DEPTH, PLE_DIM, D_MODEL), PLE_DIM ** -0.5),
        "final_g": 1.0 + nrm(ks[19], (D_MODEL,), 0.02),
    }


def reference(x_prompt, x_sample, cache_k, cache_v, p_prompt, p_sample,
              norm1_g, w_in, ln_v_g, ln_v_b, w_spatial, b_spatial, w_out,
              norm2_g, w_up, w_down, gate_norm_g, w_gate, w_ple, final_g):
    S = x_prompt.shape[1]
    T = x_sample.shape[1]
    lbuf = cache_k.shape[2]
    past = PAST_LEN
    pos_prompt = jnp.arange(S, dtype=jnp.float32)
    pos_sample = past + jnp.arange(T, dtype=jnp.float32)
    keep = min(WINDOW_MAX, S)
    hp, hs = x_prompt, x_sample
    nk_p, nv_p, nk_s, nv_s, nvc_s = [], [], [], [], []
    for i in range(DEPTH):
        q, k, v, u, vc = project(hp, pos_prompt, norm1_g[i], w_in[i])
        outs, lses = zip(*[dilated_attn_prompt(q, k, v, w, d) for (w, d) in DILATIONS])
        attn = combine_dilations(outs, lses)
        gated, _ = gmlp_gate(u, vc, ln_v_g[i], ln_v_b[i], w_spatial[i], b_spatial[i])
        hp = finish(hp, attn, gated, p_prompt[i], w_out[i], norm2_g[i], w_up[i], w_down[i],
                    gate_norm_g[i], w_gate[i], w_ple[i])
        nk_p.append(k[:, S - keep:])
        nv_p.append(v[:, S - keep:])
        q, k, v, u, vc = project(hs, pos_sample, norm1_g[i], w_in[i])
        k_all = jnp.concatenate([cache_k[i].astype(k.dtype), k], axis=1)
        v_all = jnp.concatenate([cache_v[i].astype(v.dtype), v], axis=1)
        outs, lses = zip(*[dilated_attn_sample(q, k_all, v_all, w, d, lbuf) for (w, d) in DILATIONS])
        attn = combine_dilations(outs, lses)
        gated, vn = gmlp_gate(u, vc, ln_v_g[i], ln_v_b[i], w_spatial[i], b_spatial[i])
        hs = finish(hs, attn, gated, p_sample[i], w_out[i], norm2_g[i], w_up[i], w_down[i],
                    gate_norm_g[i], w_gate[i], w_ple[i])
        nk_s.append(k)
        nv_s.append(v)
        nvc_s.append(vn)
    y_prompt = rmsnorm(hp, final_g)
    y_sample = rmsnorm(hs, final_g)
    return (y_prompt, y_sample, jnp.stack(nk_p), jnp.stack(nv_p),
            jnp.stack(nk_s), jnp.stack(nv_s), jnp.stack(nvc_s))
```

```cpp
#include <hip/hip_runtime.h>
#include <hip/hip_cooperative_groups.h>
#include <cstdio>
#include <cstdint>
namespace cg = cooperative_groups;

#ifndef MK_MASK
#define MK_MASK 511
#endif
#ifndef MK_ONE_LAUNCH
#define MK_ONE_LAUNCH 1
#endif

namespace pg8 {
#define PG8_LAS __attribute__((address_space(3)))
typedef unsigned short bf16_t;
typedef short bf16x8 __attribute__((ext_vector_type(8)));
typedef float f32x4 __attribute__((ext_vector_type(4)));
typedef unsigned u32x4 __attribute__((ext_vector_type(4)));
constexpr int BM = 256, BK = 64, HALF = 128, HTB = HALF * BK * 2  , STAGE_BYTES = 8 * HTB, NXCD = 8, WGM = 8;

__host__ __device__ __forceinline__ int lds_byte(int r, int c) { const int st = (r >> 4) * 2 + (c >> 5), rr = r & 15, cc = c & 31, ob = rr * 64 + cc * 2; return st * 1024 + (ob ^ (((ob >> 9) & 1) << 5)); }
__host__ __device__ __forceinline__ void stage_rc(int b, int& R, int& C) { const int st = b / 1024, sb = b % 1024, swz = sb ^ (((sb >> 9) & 1) << 5); R = (st >> 1) * 16 + swz / 64; C = (st & 1) * 32 + (swz % 64) / 2; }
__host__ __device__ __forceinline__ int perm32(int rho) { const int n = rho >> 4, i = rho & 15; return 8 * (i >> 2) + 4 * n + (i & 3); }

struct Unit { int pm, pn; };
struct Gemm { const bf16_t* A; const bf16_t* Bt; int M, N, K; };

struct StaticOrder {
    int nM, nN, nwg, G, c;
    __host__ __device__ void init(int M, int N, int G_, int c_) { nM = M / BM; nN = N / BM; nwg = nM * nN; G = G_; c = c_; }
    __host__ __device__ bool next(int i, Unit& u) const {
        const long L = (long)i * G + c; if (L >= nwg) return false;
        int wgid = (int)L; { const int q = nwg / NXCD, r = nwg % NXCD, xcd = wgid % NXCD, off = wgid / NXCD; wgid = (xcd < r ? xcd * (q + 1) : r * (q + 1) + (xcd - r) * q) + off; }
        const int nig = WGM * nN, gid = wgid / nig, fm = gid * WGM, gsz = (nM - fm) < WGM ? (nM - fm) : WGM;
        u.pm = fm + ((wgid % nig) % gsz); u.pn = (wgid % nig) / gsz; return true;
    }
    __device__ __forceinline__ void a_ready(const Unit&) const {}
    __device__ __forceinline__ void done(const Unit&) const {}
};

typedef unsigned u32x2 __attribute__((ext_vector_type(2)));
typedef float f32x2 __attribute__((ext_vector_type(2)));
typedef __bf16 bf16x2_cv __attribute__((ext_vector_type(2)));
__device__ __forceinline__ unsigned cvt_pk_bf16(float lo, float hi) { const f32x2 v = {lo, hi}; const bf16x2_cv b = __builtin_convertvector(v, bf16x2_cv); return __builtin_bit_cast(unsigned, b); }
__device__ __forceinline__ float gelu_tanh(float x) {
    const float z = x * (1.0f + 0.044715f * x * x);
    return x * __builtin_amdgcn_rcpf(1.0f + __builtin_amdgcn_exp2f(-2.302208198f * z));
}
__device__ __forceinline__ f32x4 gelu4(f32x4 v) { return (f32x4){gelu_tanh(v[0]), gelu_tanh(v[1]), gelu_tanh(v[2]), gelu_tanh(v[3])}; }
__device__ __forceinline__ f32x4 shfl4(f32x4 v, int m) { return (f32x4){__shfl_xor(v[0], m), __shfl_xor(v[1], m), __shfl_xor(v[2], m), __shfl_xor(v[3], m)}; }
__device__ __forceinline__ u32x4 pack8(f32x4 a, f32x4 b) { u32x4 w; w.x = cvt_pk_bf16(a[0], a[1]); w.y = cvt_pk_bf16(a[2], a[3]); w.z = cvt_pk_bf16(b[0], b[1]); w.w = cvt_pk_bf16(b[2], b[3]); return w; }
__device__ __forceinline__ u32x2 pack4(f32x4 a) { u32x2 w; w.x = cvt_pk_bf16(a[0], a[1]); w.y = cvt_pk_bf16(a[2], a[3]); return w; }
__device__ __forceinline__ float bf2f(unsigned short b) { return __uint_as_float((unsigned)b << 16); }
__device__ __forceinline__ f32x4 unpack4(u32x2 w) { return (f32x4){__uint_as_float(w.x << 16), __uint_as_float(w.x & 0xffff0000u), __uint_as_float(w.y << 16), __uint_as_float(w.y & 0xffff0000u)}; }
constexpr float QSCALE = 0.125f * 1.4426950408889634f;
constexpr float EPS = 1e-6f;


struct EpiIn {
    static constexpr bool PERM = true, AFTER_DRAIN = false;
    bf16_t *Q, *Kb, *Vb, *U, *VC; const float* rope; float* outk; float* outv;
    __device__ __forceinline__ void operator()(const f32x4 (&acc)[2][2][4][2], const Unit& u, int wr, int wc, int fr, int fq) const {
        const int seg = u.pn >> 1;
        const int row0 = u.pm * BM + wr * 64 + fr, lc0 = (u.pn & 1) * 256 + wc * 32 + 8 * fq;
        bf16_t* base = seg == 0 ? Q : seg == 1 ? Kb : seg == 2 ? Vb : seg == 3 ? U : VC;
        float* fout = seg == 1 ? outk : outv;
        const bool ropeseg = (seg < 2) && ((wc & 1) == 0);
#pragma unroll
        for (int ai = 0; ai < 2; ++ai)
#pragma unroll
            for (int m = 0; m < 4; ++m) {
                const int row = row0 + ai * HALF + m * 16;
                f32x4 c0 = {1.f, 1.f, 1.f, 1.f}, c1 = c0, s0 = {0.f, 0.f, 0.f, 0.f}, s1 = s0;
                if (ropeseg) { const f32x4* rp = (const f32x4*)(rope + (size_t)row * 16); c0 = rp[0]; c1 = rp[1]; s0 = rp[2]; s1 = rp[3]; if (fq == 0) { s0 = -s0; s1 = -s1; } if (fq >= 2) { c0 = (f32x4){1.f, 1.f, 1.f, 1.f}; c1 = c0; s0 = (f32x4){0.f, 0.f, 0.f, 0.f}; s1 = s0; } }
#pragma unroll
                for (int bj = 0; bj < 2; ++bj) {
                    f32x4 v0 = acc[ai][bj][m][0], v1 = acc[ai][bj][m][1];
                    if (ropeseg) { const f32x4 p0 = shfl4(v0, 16), p1 = shfl4(v1, 16); v0 = v0 * c0 + p0 * s0; v1 = v1 * c1 + p1 * s1; }
                    if (seg == 0) { v0 = v0 * QSCALE; v1 = v1 * QSCALE; }
                    if (seg >= 3) { v0 = gelu4(v0); v1 = gelu4(v1); }
                    const size_t off = (size_t)row * 512 + lc0 + bj * HALF;
                    *(u32x4*)(base + off) = pack8(v0, v1);
                    if ((seg == 1 || seg == 2) && row >= 16384 - 2048) { float* o = fout + (size_t)(row - (16384 - 2048)) * 512 + lc0 + bj * HALF; *(f32x4*)o = v0; *(f32x4*)(o + 4) = v1; }
                }
                asm volatile("" ::: "memory");
            }
    }
};
struct EpiBf {
    static constexpr bool PERM = true, AFTER_DRAIN = false;
    bf16_t* O; static constexpr int ldc = 1024;
    __device__ __forceinline__ void operator()(const f32x4 (&acc)[2][2][4][2], const Unit& u, int wr, int wc, int fr, int fq) const {
        const int row0 = u.pm * BM + wr * 64 + fr, col0 = u.pn * BM + wc * 32 + 8 * fq;
#pragma unroll
        for (int ai = 0; ai < 2; ++ai)
#pragma unroll
            for (int m = 0; m < 4; ++m)
#pragma unroll
                for (int bj = 0; bj < 2; ++bj) *(u32x4*)(O + (size_t)(row0 + ai * HALF + m * 16) * ldc + col0 + bj * HALF) = pack8(acc[ai][bj][m][0], acc[ai][bj][m][1]);
    }
};
__device__ __forceinline__ float rstd_from_slots16(const float* p) {
    const f32x4 a = ((const f32x4*)p)[0], b = ((const f32x4*)p)[1], c = ((const f32x4*)p)[2], d = ((const f32x4*)p)[3];
    const float s = ((a[0] + a[1]) + (a[2] + a[3])) + ((b[0] + b[1]) + (b[2] + b[3])) + ((c[0] + c[1]) + (c[2] + c[3])) + ((d[0] + d[1]) + (d[2] + d[3]));
    return 1.0f / sqrtf(s * (1.0f / 1024.0f) + EPS);
}
struct EpiUp {
    static constexpr bool PERM = true, AFTER_DRAIN = false;
    bf16_t* O; const float* ssq;
    __device__ __forceinline__ void operator()(const f32x4 (&acc)[2][2][4][2], const Unit& u, int wr, int wc, int fr, int fq) const {
        const int row0 = u.pm * BM + wr * 64 + fr, col0 = u.pn * BM + wc * 32 + 8 * fq;
#pragma unroll
        for (int ai = 0; ai < 2; ++ai)
#pragma unroll
            for (int m = 0; m < 4; ++m) { const int row = row0 + ai * HALF + m * 16; const float rs = rstd_from_slots16(ssq + (size_t)row * 16);
#pragma unroll
                for (int bj = 0; bj < 2; ++bj) { f32x4 v0 = acc[ai][bj][m][0] * rs, v1 = acc[ai][bj][m][1] * rs;
#pragma unroll
                    for (int e = 0; e < 4; ++e) { v0[e] = fmaxf(v0[e], 0.f); v0[e] *= v0[e]; v1[e] = fmaxf(v1[e], 0.f); v1[e] *= v1[e]; }
                    *(u32x4*)(O + (size_t)row * 4096 + col0 + bj * HALF) = pack8(v0, v1); } }
    }
};
template <bool BASE_F32> struct EpiRes {
    static constexpr bool PERM = false, AFTER_DRAIN = false;
    const void* base; bf16_t* outb; float* ssq;
    __device__ __forceinline__ void operator()(const f32x4 (&acc)[2][2][4][2], const Unit& u, int wr, int wc, int fr, int fq) const {
        const int row0 = u.pm * BM + wr * 64 + fr, col0 = u.pn * BM + wc * 32 + 4 * fq;
#pragma unroll
        for (int ai = 0; ai < 2; ++ai) {
            f32x4 pre[4][2][2];
#pragma unroll
            for (int m = 0; m < 4; ++m)
#pragma unroll
                for (int bj = 0; bj < 2; ++bj)
#pragma unroll
                    for (int n = 0; n < 2; ++n) { const size_t c = (size_t)(row0 + ai * HALF + m * 16) * 1024 + col0 + bj * HALF + n * 16;
                        pre[m][bj][n] = BASE_F32 ? *(const f32x4*)((const float*)base + c) : unpack4(*(const u32x2*)((const bf16_t*)base + c)); }
#pragma unroll
            for (int m = 0; m < 4; ++m) { const int row = row0 + ai * HALF + m * 16; const size_t off = (size_t)row * 1024 + col0; float s = 0.f;
#pragma unroll
                for (int bj = 0; bj < 2; ++bj)
#pragma unroll
                    for (int n = 0; n < 2; ++n) { const size_t c = off + bj * HALF + n * 16;
                        const u32x2 w = pack4(pre[m][bj][n] + acc[ai][bj][m][n]); const f32x4 o = unpack4(w);
                        s += (o[0] * o[0] + o[1] * o[1]) + (o[2] * o[2] + o[3] * o[3]); *(u32x2*)(outb + c) = w; }
                s += __shfl_xor(s, 16); s += __shfl_xor(s, 32);
                if (fq == 0) ssq[(size_t)row * 16 + u.pn * 4 + wc] = s; }
            asm volatile("" ::: "memory");
        }
    }
};
struct EpiGateFinal {
    static constexpr bool PERM = false, AFTER_DRAIN = true;
    const bf16_t* h2; const bf16_t* ple; const float* ssq_in; const float* fgain; float* out; float* slots; unsigned* cnt;
    __device__ __forceinline__ void fused(f32x4 (&acc)[2][2][4][2], const Unit& u, int wr, int wc, int fr, int fq, PG8_LAS unsigned char* lds, int wid, int lane) const {
        const int row0 = u.pm * BM + wr * 64 + fr, col0 = u.pn * BM + wc * 32 + 4 * fq;
        PG8_LAS float* RS = (PG8_LAS float*)lds;
#pragma unroll
        for (int ai = 0; ai < 2; ++ai)
#pragma unroll
            for (int m = 0; m < 4; ++m) { const int row = row0 + ai * HALF + m * 16; const size_t off = (size_t)row * 1024 + col0; float s = 0.f;
                const float rs = rstd_from_slots16(ssq_in + (size_t)row * 16);
#pragma unroll
                for (int bj = 0; bj < 2; ++bj)
#pragma unroll
                    for (int n = 0; n < 2; ++n) { const size_t c = off + bj * HALF + n * 16; const f32x4 z = acc[ai][bj][m][n] * rs; const f32x4 pl = unpack4(*(const u32x2*)(ple + c)); f32x4 o = unpack4(*(const u32x2*)(h2 + c));
#pragma unroll
                        for (int e = 0; e < 4; ++e) o[e] += pl[e] * __builtin_amdgcn_rcpf(1.0f + __builtin_amdgcn_exp2f(-1.4426950408889634f * z[e]));
                        s += (o[0] * o[0] + o[1] * o[1]) + (o[2] * o[2] + o[3] * o[3]); acc[ai][bj][m][n] = o; }
                s += __shfl_xor(s, 16); s += __shfl_xor(s, 32);
                if (fq == 0) __hip_atomic_store(slots + (size_t)row * 16 + u.pn * 4 + wc, s, __ATOMIC_RELAXED, __HIP_MEMORY_SCOPE_AGENT);
                asm volatile("" : "+v"(acc[ai][0][m][0]), "+v"(acc[ai][0][m][1]), "+v"(acc[ai][1][m][0]), "+v"(acc[ai][1][m][1]));
                if (m & 1) asm volatile("" ::: "memory"); }
        asm volatile("s_waitcnt vmcnt(0)" ::: "memory");
        if (lane == 0) __hip_atomic_fetch_add(cnt + 64 * u.pm, 1u, __ATOMIC_RELEASE, __HIP_MEMORY_SCOPE_AGENT);
        if (wid == 0) {
            unsigned spins = 0;
            while ((unsigned)__builtin_amdgcn_readfirstlane(__hip_atomic_load(cnt + 64 * u.pm, __ATOMIC_RELAXED, __HIP_MEMORY_SCOPE_AGENT)) < 32u && ++spins < (1u << 22)) __builtin_amdgcn_s_sleep(2);
            __builtin_amdgcn_fence(__ATOMIC_ACQUIRE, "agent");
        }
        asm volatile("s_waitcnt vmcnt(0) lgkmcnt(0)" ::: "memory"); __builtin_amdgcn_s_barrier(); asm volatile("" ::: "memory");
        { const int tid = wid * 64 + lane;
          const float* sp = slots + (size_t)(u.pm * BM + (tid >> 1)) * 16 + 8 * (tid & 1); float t = 0.f;
#pragma unroll
          for (int e = 0; e < 8; ++e) t += __hip_atomic_load(sp + e, __ATOMIC_RELAXED, __HIP_MEMORY_SCOPE_AGENT);
          t += __shfl_xor(t, 1);
          if ((tid & 1) == 0) RS[tid >> 1] = 1.0f / sqrtf(t * (1.0f / 1024.0f) + EPS); }
        asm volatile("s_waitcnt lgkmcnt(0)" ::: "memory"); __builtin_amdgcn_s_barrier(); asm volatile("" ::: "memory");
        f32x4 gg[2][2];
#pragma unroll
        for (int bj = 0; bj < 2; ++bj)
#pragma unroll
            for (int n = 0; n < 2; ++n) gg[bj][n] = *(const f32x4*)(fgain + col0 + bj * HALF + n * 16);
#pragma unroll
        for (int ai = 0; ai < 2; ++ai)
#pragma unroll
            for (int m = 0; m < 4; ++m) { const int r = ai * HALF + wr * 64 + m * 16 + fr; const float rs = RS[r]; const size_t off = (size_t)(u.pm * BM + r) * 1024 + col0;
#pragma unroll
                for (int bj = 0; bj < 2; ++bj)
#pragma unroll
                    for (int n = 0; n < 2; ++n) *(f32x4*)(out + off + bj * HALF + n * 16) = acc[ai][bj][m][n] * rs * gg[bj][n]; }
    }
};
template <class Epi, class Sched, bool ALIGN_EPI = false, bool SP2 = false>
__device__ __forceinline__ void gemm_phase(PG8_LAS unsigned char* lds, const Gemm g, const Sched& S, const Epi& E) {
    const int tid = threadIdx.x, wid = __builtin_amdgcn_readfirstlane(tid >> 6), lane = tid & 63, wr = wid >> 2, wc = wid & 3, fr = lane & 15, fq = lane >> 4;
    const int K = g.K, nt = K / BK;
    unsigned voffA[2], voffB[2];
#pragma unroll
    for (int i = 0; i < 2; ++i) { int R, C; stage_rc(tid * 16 + i * 8192, R, C); const int Rb = Epi::PERM ? ((R & ~31) + perm32(R & 31)) : R;
        voffA[i] = (unsigned)(R * K + C) * 2u; voffB[i] = (unsigned)(Rb * K + C) * 2u; }
    const size_t kstep = (size_t)(BK * 2);
    const size_t hstep = (size_t)HALF * K * 2;
    const size_t tstep = 2 * hstep;
    const unsigned ldsw = (unsigned)wid * 1024u;
    const int aoff = lds_byte(wr * 64 + fr, fq * 8), boff = lds_byte(wc * 32 + fr, fq * 8);
#define PG8_SA(b, h) (((b) * 2 + (h)) * HTB)
#define PG8_SB(b, h) ((4 + (b) * 2 + (h)) * HTB)
#define PG8_STAGE(bufoff, gbase, voff) do { _Pragma("unroll") for (int _i = 0; _i < 2; ++_i) \
        __builtin_amdgcn_global_load_lds((const unsigned*)((const char*)(gbase) + (voff)[_i]), (PG8_LAS unsigned*)(lds + (bufoff) + ldsw + _i * 8192), 16, 0, 0); } while (0)
#define PG8_LDA(dst, b, h) do { _Pragma("unroll") for (int m = 0; m < 4; ++m) _Pragma("unroll") for (int k = 0; k < 2; ++k) dst[m][k] = *(const PG8_LAS bf16x8*)(lds + PG8_SA(b, h) + aoff + m * 2048 + k * 1024); } while (0)
#define PG8_LDB(dst, b, h) do { _Pragma("unroll") for (int n = 0; n < 2; ++n) _Pragma("unroll") for (int k = 0; k < 2; ++k) dst[n][k] = *(const PG8_LAS bf16x8*)(lds + PG8_SB(b, h) + boff + n * 2048 + k * 1024); } while (0)
#define PG8_MMA(ai, bj, At, Bt) do { __builtin_amdgcn_s_setprio(1); _Pragma("unroll") for (int m = 0; m < 4; ++m) _Pragma("unroll") for (int n = 0; n < 2; ++n) _Pragma("unroll") for (int k = 0; k < 2; ++k) \
        acc[ai][bj][m][n] = __builtin_amdgcn_mfma_f32_16x16x32_bf16(Bt[n][k], At[m][k], acc[ai][bj][m][n], 0, 0, 0); __builtin_amdgcn_s_setprio(0); } while (0)
#define PG8_WAIT_V(n) asm volatile("s_waitcnt vmcnt(" #n ")" ::: "memory")
#define PG8_WAIT_L(n) asm volatile("s_waitcnt lgkmcnt(" #n ")" ::: "memory")
#define PG8_BAR __builtin_amdgcn_s_barrier()
#define PG8_SCHED __builtin_amdgcn_sched_barrier(0)
    Unit cur, nxt; int ui = 0;
    if (!S.next(0, cur)) return;
    f32x4 acc[2][2][4][2];
#pragma unroll
    for (int a = 0; a < 2; ++a)
#pragma unroll
        for (int b = 0; b < 2; ++b)
#pragma unroll
            for (int m = 0; m < 4; ++m)
#pragma unroll
                for (int n = 0; n < 2; ++n) acc[a][b][m][n] = (f32x4){0.f, 0.f, 0.f, 0.f};
    bf16x8 At[4][2], B0[2][2], B1[2][2];
    const char* cA = (const char*)g.A + (size_t)cur.pm * tstep; const char* cB = (const char*)g.Bt + (size_t)cur.pn * tstep;
    S.a_ready(cur);
    if constexpr (SP2) {
        PG8_STAGE(PG8_SB(0, 0), cB, voffB); PG8_STAGE(PG8_SB(0, 1), cB + hstep, voffB); PG8_STAGE(PG8_SA(0, 0), cA, voffA); PG8_STAGE(PG8_SA(0, 1), cA + hstep, voffA);
        if (wr == 1) PG8_BAR;
        PG8_WAIT_V(2); PG8_BAR;
        PG8_STAGE(PG8_SB(1, 0), cB + kstep, voffB); PG8_STAGE(PG8_SA(1, 0), cA + kstep, voffA); PG8_STAGE(PG8_SB(1, 1), cB + hstep + kstep, voffB);
        PG8_WAIT_V(6); PG8_BAR;
    } else {
        PG8_STAGE(PG8_SB(0, 0), cB, voffB); PG8_STAGE(PG8_SA(0, 0), cA, voffA); PG8_STAGE(PG8_SB(0, 1), cB + hstep, voffB); PG8_STAGE(PG8_SA(0, 1), cA + hstep, voffA);
        if (wr == 1) PG8_BAR;
        PG8_WAIT_V(4); PG8_BAR;
        PG8_STAGE(PG8_SB(1, 0), cB + kstep, voffB); PG8_STAGE(PG8_SA(1, 0), cA + kstep, voffA); PG8_STAGE(PG8_SB(1, 1), cB + hstep + kstep, voffB);
        PG8_WAIT_V(6); PG8_BAR;
    }
    for (;;) {
        const bool has_next = S.next(ui + 1, nxt);
        const char* nA = has_next ? (const char*)g.A + (size_t)nxt.pm * tstep : cA; const char* nB = has_next ? (const char*)g.Bt + (size_t)nxt.pn * tstep : cB;
        for (int t = 0; t < nt; t += 2) {
            const bool last = (t == nt - 2);
            const char* a1 = cA + (size_t)(t + 1) * kstep;
            const char* a2 = last ? nA : cA + (size_t)(t + 2) * kstep; const char* b2 = last ? nB : cB + (size_t)(t + 2) * kstep;
            const char* a3 = a2 + kstep; const char* b3 = b2 + kstep;
            if (last && has_next) S.a_ready(nxt);
            if constexpr (SP2) {
            PG8_LDB(B0, 0, 0); PG8_LDB(B1, 0, 1); PG8_SCHED; PG8_LDA(At, 0, 0); PG8_STAGE(PG8_SA(1, 1), a1 + hstep, voffA);
            PG8_WAIT_V(8); PG8_WAIT_L(0); PG8_BAR; PG8_MMA(0, 0, At, B0); PG8_MMA(0, 1, At, B1); PG8_BAR; PG8_SCHED;
            PG8_LDA(At, 0, 1); PG8_STAGE(PG8_SB(0, 0), b2, voffB); PG8_STAGE(PG8_SB(0, 1), b2 + hstep, voffB); PG8_STAGE(PG8_SA(0, 0), a2, voffA);
            PG8_WAIT_V(8); PG8_WAIT_L(0); PG8_BAR; PG8_MMA(1, 0, At, B0); PG8_MMA(1, 1, At, B1); PG8_BAR; PG8_SCHED;
            PG8_LDB(B0, 1, 0); PG8_LDB(B1, 1, 1); PG8_SCHED; PG8_LDA(At, 1, 0); PG8_STAGE(PG8_SA(0, 1), a2 + hstep, voffA);
            PG8_WAIT_V(8); PG8_WAIT_L(0); PG8_BAR; PG8_MMA(0, 0, At, B0); PG8_MMA(0, 1, At, B1); PG8_BAR; PG8_SCHED;
            PG8_LDA(At, 1, 1); PG8_STAGE(PG8_SB(1, 0), b3, voffB); PG8_STAGE(PG8_SB(1, 1), b3 + hstep, voffB); PG8_STAGE(PG8_SA(1, 0), a3, voffA);
            PG8_WAIT_V(8); PG8_WAIT_L(0); PG8_BAR; PG8_MMA(1, 0, At, B0); PG8_MMA(1, 1, At, B1); PG8_BAR; PG8_SCHED;
            } else {
            PG8_LDB(B0, 0, 0); PG8_SCHED; PG8_LDA(At, 0, 0); PG8_STAGE(PG8_SA(1, 1), a1 + hstep, voffA);
            PG8_WAIT_L(8); PG8_BAR; PG8_WAIT_L(0); PG8_MMA(0, 0, At, B0); PG8_BAR; PG8_SCHED;
            PG8_LDB(B1, 0, 1); PG8_STAGE(PG8_SB(0, 0), b2, voffB);
            PG8_BAR; PG8_WAIT_L(0); PG8_MMA(0, 1, At, B1); PG8_BAR;
            PG8_LDA(At, 0, 1); PG8_STAGE(PG8_SA(0, 0), a2, voffA);
            PG8_BAR; PG8_WAIT_L(0); PG8_MMA(1, 0, At, B0); PG8_BAR; PG8_SCHED;
            PG8_STAGE(PG8_SB(0, 1), b2 + hstep, voffB);
            PG8_WAIT_V(6); PG8_BAR; PG8_MMA(1, 1, At, B1); PG8_BAR;
            PG8_LDB(B0, 1, 0); PG8_SCHED; PG8_LDA(At, 1, 0); PG8_STAGE(PG8_SA(0, 1), a2 + hstep, voffA);
            PG8_WAIT_L(8); PG8_BAR; PG8_WAIT_L(0); PG8_MMA(0, 0, At, B0); PG8_BAR; PG8_SCHED;
            PG8_LDB(B1, 1, 1); PG8_STAGE(PG8_SB(1, 0), b3, voffB);
            PG8_BAR; PG8_WAIT_L(0); PG8_MMA(0, 1, At, B1); PG8_BAR;
            PG8_LDA(At, 1, 1); PG8_STAGE(PG8_SA(1, 0), a3, voffA);
            PG8_BAR; PG8_WAIT_L(0); PG8_MMA(1, 0, At, B0); PG8_BAR; PG8_SCHED;
            PG8_STAGE(PG8_SB(1, 1), b3 + hstep, voffB);
            PG8_WAIT_V(6); PG8_BAR; PG8_MMA(1, 1, At, B1); PG8_BAR;
            }
        }
        if constexpr (ALIGN_EPI) { if (wr == 0) PG8_BAR; }
        if constexpr (!Epi::AFTER_DRAIN) { E(acc, cur, wr, wc, fr, fq); S.done(cur); }
        if (!has_next) break;
#pragma unroll
        for (int a = 0; a < 2; ++a)
#pragma unroll
            for (int b = 0; b < 2; ++b)
#pragma unroll
                for (int m = 0; m < 4; ++m)
#pragma unroll
                    for (int n = 0; n < 2; ++n) acc[a][b][m][n] = (f32x4){0.f, 0.f, 0.f, 0.f};
        cur = nxt; cA = nA; cB = nB; ++ui;
        if constexpr (ALIGN_EPI) { if (wr == 1) PG8_BAR; }
    }
    PG8_WAIT_V(0);
    if constexpr (!ALIGN_EPI) { if (wr == 0) PG8_BAR; }
    PG8_BAR;
    if constexpr (Epi::AFTER_DRAIN) { E.fused(acc, cur, wr, wc, fr, fq, lds, wid, lane); S.done(cur); }
#undef PG8_SA
#undef PG8_SB
#undef PG8_STAGE
#undef PG8_LDA
#undef PG8_LDB
#undef PG8_MMA
#undef PG8_WAIT_V
#undef PG8_WAIT_L
#undef PG8_BAR
#undef PG8_SCHED
}
}
using pg8::bf16_t; using pg8::bf16x8; using pg8::f32x4; using pg8::u32x4; using pg8::u32x2; using pg8::cvt_pk_bf16; using pg8::pack4; using pg8::pack8; using pg8::unpack4; using pg8::QSCALE; using pg8::EPS;
#define LAS __attribute__((address_space(3)))
typedef float f32x16 __attribute__((ext_vector_type(16)));
typedef short s16x4 __attribute__((ext_vector_type(4)));

constexpr int SEQ = 16384, DM = 1024, NSAMP = 128, MTOT = SEQ + NSAMP, INW = 2560, DFF = 4096, PLE = 256, PAST = 16384, LBUF = 2048;
constexpr int NWAVES = 8;

__device__ __forceinline__ int crow(int r, int hi) { return (r & 3) + 8 * (r >> 2) + 4 * hi; }
__device__ __forceinline__ s16x4 tr_read(const LAS unsigned char* p) { return __builtin_bit_cast(s16x4, __builtin_amdgcn_ds_read_tr16_b64_v4i16((LAS s16x4*)p)); }

constexpr int AK_PITCH = 144, AV_OFF = 384 * AK_PITCH;
struct AttnPre { u32x4 kv[6], vv[6]; };
__device__ __forceinline__ void attn_decode(int a, int& head, int& di, int& dil, int& r, int& m0) {
    head = a & 7; const int t = a >> 3; di = t >> 6; const int rng = t & 63;
    dil = di == 0 ? 1 : di == 1 ? 4 : 16; const int sh = di == 0 ? 6 : di == 1 ? 4 : 2;
    r = rng >> sh; m0 = (rng & ((1 << sh) - 1)) * 256;
}
__device__ __forceinline__ void attn_prefetch(AttnPre& P, int a, const bf16_t* K, const bf16_t* V) {
    int head, di, dil, r, m0; attn_decode(a, head, di, dil, r, m0); const int tid = threadIdx.x;
#pragma unroll
    for (int i = 0; i < 6; ++i) {
        const int id = tid + 512 * i, row = id >> 3, ch = id & 7, m = m0 - 128 + row;
        P.kv[i] = (u32x4){0u, 0u, 0u, 0u}; P.vv[i] = P.kv[i];
        if (m >= 0) { const size_t g = (size_t)(m * dil + r) * 512 + head * 64 + ch * 8; P.kv[i] = *(const u32x4*)(K + g); P.vv[i] = *(const u32x4*)(V + g); }
    }
}
__device__ __forceinline__ void attn_unit(LAS unsigned char* lds, int a, int anext, bool has_next, AttnPre& P, const bf16_t* Q, const bf16_t* K, const bf16_t* V, bf16_t* OU, float* LSE) {
    const int tid = threadIdx.x, lane = tid & 63, r32 = lane & 31, hi = lane >> 5; const int w = __builtin_amdgcn_readfirstlane(tid >> 6);
    int head, di, dil, r, m0; attn_decode(a, head, di, dil, r, m0);
    __syncthreads();
#pragma unroll
    for (int i = 0; i < 6; ++i) {
        const int id = tid + 512 * i, row = id >> 3, ch = id & 7;
        *(LAS u32x4*)(lds + row * AK_PITCH + ch * 16) = P.kv[i];
        *(LAS u32x4*)(lds + AV_OFF + (row >> 3) * 1024 + (ch >> 2) * 512 + (row & 7) * 64 + (ch & 3) * 16) = P.vv[i];
    }
    const int posq = (m0 + 32 * w + r32) * dil + r;
    bf16x8 qf[4];
#pragma unroll
    for (int ds = 0; ds < 4; ++ds) qf[ds] = *(const bf16x8*)(Q + (size_t)posq * 512 + head * 64 + ds * 16 + hi * 8);
    __syncthreads();
    if (has_next) attn_prefetch(P, anext, K, V);
    f32x16 s[5];
    const LAS unsigned char* kb = lds + (32 * w + r32) * AK_PITCH + hi * 16;
#pragma unroll
    for (int kt = 0; kt < 5; ++kt) {
        f32x16 c = {};
#pragma unroll
        for (int ds = 0; ds < 4; ++ds) { const bf16x8 kf = *(const LAS bf16x8*)(kb + kt * 32 * AK_PITCH + ds * 32); c = __builtin_amdgcn_mfma_f32_32x32x16_bf16(kf, qf[ds], c, 0, 0, 0); }
        s[kt] = c; __builtin_amdgcn_sched_barrier(0);
    }
#pragma unroll
    for (int i = 0; i < 16; ++i) { if (crow(i, hi) < r32) s[0][i] = -1e30f; if (crow(i, hi) > r32) s[4][i] = -1e30f; }
    const int kmin = 128 - m0 - 32 * w;
    if (kmin > 0) {
#pragma unroll
        for (int kt = 0; kt < 5; ++kt)
#pragma unroll
            for (int i = 0; i < 16; ++i) if (32 * kt + crow(i, hi) < kmin) s[kt][i] = -1e30f;
    }
    float mx = -1e30f;
#pragma unroll
    for (int kt = 0; kt < 5; ++kt)
#pragma unroll
        for (int i = 0; i < 16; ++i) mx = fmaxf(mx, s[kt][i]);
    mx = fmaxf(mx, __shfl_xor(mx, 32));
    float den = 0.f;
#pragma unroll
    for (int kt = 0; kt < 5; ++kt)
#pragma unroll
        for (int i = 0; i < 16; ++i) { const float p = __builtin_amdgcn_exp2f(s[kt][i] - mx); s[kt][i] = p; den += p; }
    den += __shfl_xor(den, 32);
    f32x16 o[2]; o[0] = f32x16{}; o[1] = f32x16{};
    const LAS unsigned char* vb = lds + AV_OFF + (4 * w) * 1024 + (4 * hi + ((lane & 15) >> 2)) * 64 + ((lane >> 4) & 1) * 32 + (lane & 3) * 8;
#pragma unroll
    for (int kt = 0; kt < 5; ++kt)
#pragma unroll
        for (int s2 = 0; s2 < 2; ++s2) {
            u32x4 pw; pw.x = cvt_pk_bf16(s[kt][8 * s2 + 0], s[kt][8 * s2 + 1]); pw.y = cvt_pk_bf16(s[kt][8 * s2 + 2], s[kt][8 * s2 + 3]); pw.z = cvt_pk_bf16(s[kt][8 * s2 + 4], s[kt][8 * s2 + 5]); pw.w = cvt_pk_bf16(s[kt][8 * s2 + 6], s[kt][8 * s2 + 7]);
            const bf16x8 pa = __builtin_bit_cast(bf16x8, pw);
#pragma unroll
            for (int d0 = 0; d0 < 2; ++d0) {
                const s16x4 lo = tr_read(vb + (4 * kt + 2 * s2) * 1024 + d0 * 512), hh = tr_read(vb + (4 * kt + 2 * s2 + 1) * 1024 + d0 * 512);
                const bf16x8 vf = (bf16x8){lo[0], lo[1], lo[2], lo[3], hh[0], hh[1], hh[2], hh[3]};
                o[d0] = __builtin_amdgcn_mfma_f32_32x32x16_bf16(vf, pa, o[d0], 0, 0, 0);
            }
            __builtin_amdgcn_sched_barrier(0);
        }
    const float rden = 1.0f / den;
    bf16_t* op = OU + ((size_t)di * SEQ + posq) * 512 + head * 64 + 4 * hi;
#pragma unroll
    for (int d0 = 0; d0 < 2; ++d0)
#pragma unroll
        for (int i4 = 0; i4 < 4; ++i4) { u32x2 wv; wv.x = cvt_pk_bf16(o[d0][4 * i4] * rden, o[d0][4 * i4 + 1] * rden); wv.y = cvt_pk_bf16(o[d0][4 * i4 + 2] * rden, o[d0][4 * i4 + 3] * rden); *(u32x2*)(op + 32 * d0 + 8 * i4) = wv; }
    if (hi == 0) LSE[((size_t)di * SEQ + posq) * 8 + head] = mx + __builtin_amdgcn_logf(den);
}

__device__ __forceinline__ void gmlp_unit(LAS unsigned char* lds, int unit, const bf16_t* VC, const bf16_t* U, const float* lng, const float* lnb, const bf16_t* Wsb, const float* bsp, bf16_t* MIX) {
    const int tid = threadIdx.x, lane = tid & 63, r32 = lane & 31, hi = lane >> 5; const int w = __builtin_amdgcn_readfirstlane(tid >> 6);
    const int c = unit >> 1, hf = unit & 1;
    __syncthreads();
    {
        const int tk = tid >> 2, qd = tid & 3; const bf16_t* src = VC + (size_t)(c * 128 + tk) * 512 + qd * 128;
        u32x4 raw[16]; float sum = 0.f;
#pragma unroll
        for (int i = 0; i < 16; ++i) { raw[i] = *(const u32x4*)(src + 8 * i);
#pragma unroll
            for (int e = 0; e < 4; ++e) sum += __uint_as_float(raw[i][e] << 16) + __uint_as_float(raw[i][e] & 0xffff0000u); }
        sum += __shfl_xor(sum, 1); sum += __shfl_xor(sum, 2);
        const float mean = sum * (1.0f / 512.0f); float sq = 0.f;
#pragma unroll
        for (int i = 0; i < 16; ++i)
#pragma unroll
            for (int e = 0; e < 4; ++e) { const float a = __uint_as_float(raw[i][e] << 16) - mean, b = __uint_as_float(raw[i][e] & 0xffff0000u) - mean; sq += a * a + b * b; }
        sq += __shfl_xor(sq, 1); sq += __shfl_xor(sq, 2);
        const float rstd = 1.0f / sqrtf(sq * (1.0f / 512.0f) + EPS);
        if ((qd >> 1) == hf) {
#pragma unroll
            for (int i = 0; i < 16; ++i) { const int ch = qd * 128 + 8 * i, gl = (ch >> 6) & 3, cl = ch & 63;
                const f32x4 g0 = *(const f32x4*)(lng + ch), g1 = *(const f32x4*)(lng + ch + 4), b0 = *(const f32x4*)(lnb + ch), b1 = *(const f32x4*)(lnb + ch + 4);
                f32x4 x0, x1;
                x0[0] = __uint_as_float(raw[i][0] << 16); x0[1] = __uint_as_float(raw[i][0] & 0xffff0000u); x0[2] = __uint_as_float(raw[i][1] << 16); x0[3] = __uint_as_float(raw[i][1] & 0xffff0000u);
                x1[0] = __uint_as_float(raw[i][2] << 16); x1[1] = __uint_as_float(raw[i][2] & 0xffff0000u); x1[2] = __uint_as_float(raw[i][3] << 16); x1[3] = __uint_as_float(raw[i][3] & 0xffff0000u);
                x0 = (x0 - mean) * rstd * g0 + b0; x1 = (x1 - mean) * rstd * g1 + b1;
                *(LAS u32x4*)(lds + gl * 16384 + (tk >> 3) * 1024 + (cl >> 5) * 512 + (tk & 7) * 64 + (cl & 31) * 2) = pack8(x0, x1); }
        }
    }
    __syncthreads();
    const int gl = w & 3, g = 4 * hf + gl;
    const LAS unsigned char* vb = lds + gl * 16384 + (lane & 12) * 16 + ((lane >> 4) & 1) * 32 + (lane & 3) * 8;
    const bf16_t* wg = Wsb + (size_t)g * 128 * 128;
#pragma unroll 1
    for (int q = 0; q < 2; ++q) {
        const int mt = (w < 4) ? (q ? 3 : 0) : (q ? 2 : 1), nks = 2 * mt + 2;
        f32x16 acc[2]; acc[0] = f32x16{}; acc[1] = f32x16{};
        const bf16_t* wrow = wg + (size_t)(32 * mt + r32) * 128 + 8 * hi;
        bf16x8 wf[8];
#pragma unroll
        for (int ks = 0; ks < 8; ++ks) wf[ks] = *(const bf16x8*)(wrow + 16 * (ks < nks ? ks : 0));
        const int tok = c * 128 + 32 * mt + r32; const float bias = bsp[g * 128 + 32 * mt + r32];
        u32x2 uu[2][4];
#pragma unroll
        for (int nt = 0; nt < 2; ++nt)
#pragma unroll
            for (int i4 = 0; i4 < 4; ++i4) uu[nt][i4] = *(const u32x2*)(U + (size_t)tok * 512 + 64 * g + 32 * nt + 8 * i4 + 4 * hi);
#pragma unroll
        for (int ks = 0; ks < 8; ++ks) {
            if (ks < nks) {
#pragma unroll
                for (int nt = 0; nt < 2; ++nt) {
                    const s16x4 lo = tr_read(vb + (2 * ks + hi) * 1024 + nt * 512), hh = tr_read(vb + (2 * ks + hi) * 1024 + nt * 512 + 256);
                    const bf16x8 vf = (bf16x8){lo[0], lo[1], lo[2], lo[3], hh[0], hh[1], hh[2], hh[3]};
                    acc[nt] = __builtin_amdgcn_mfma_f32_32x32x16_bf16(vf, wf[ks], acc[nt], 0, 0, 0);
                }
            }
        }
#pragma unroll
        for (int nt = 0; nt < 2; ++nt)
#pragma unroll
            for (int i4 = 0; i4 < 4; ++i4) { const int ch = 64 * g + 32 * nt + 8 * i4 + 4 * hi;
                f32x4 mv = {acc[nt][4 * i4], acc[nt][4 * i4 + 1], acc[nt][4 * i4 + 2], acc[nt][4 * i4 + 3]};
                mv = (mv + bias) * unpack4(uu[nt][i4]); *(u32x2*)(MIX + (size_t)tok * 1024 + 512 + ch) = pack4(mv); }
    }
}
__device__ __forceinline__ float wave_sum(float v) {
#pragma unroll
    for (int o = 1; o < 64; o <<= 1) v += __shfl_xor(v, o);
    return v;
}
__device__ __forceinline__ float red16(float v) { v += __shfl_xor(v, 1); v += __shfl_xor(v, 2); v += __shfl_xor(v, 4); v += __shfl_xor(v, 8); return v; }

__device__ __forceinline__ void samp_attn_task(int t, int lane, const float* QS, const float* KS, const float* VS, const float* ck, const float* cv, float* OUS, float* LSES) {
    const int half = t & 1, t2 = t >> 1, di = t2 % 3, tq = t2 / 3, j = tq & 3, h = (tq >> 2) & 7, b = tq >> 5, kg = lane >> 4, d4 = lane & 15;
    const int dl = di == 0 ? 1 : di == 1 ? 4 : 16, i0 = 68 * half;
    const f32x4 q = *(const f32x4*)(QS + (size_t)(b * 4 + j) * 512 + h * 64 + 4 * d4);
    float s[17]; float m = -1e30f;
#pragma unroll
    for (int it = 0; it < 17; ++it) {
        const int i = i0 + 4 * it + kg; const bool ok = i <= 128; const int idx = LBUF + j - dl * (ok ? i : 128);
        const float* kp = idx >= LBUF ? KS + (size_t)(b * 4 + idx - LBUF) * 512 + h * 64 : ck + (((size_t)b * LBUF + idx) * 8 + h) * 64;
        const f32x4 kv = *(const f32x4*)(kp + 4 * d4);
        float p = (q[0] * kv[0] + q[1] * kv[1]) + (q[2] * kv[2] + q[3] * kv[3]);
        p = red16(p); p = ok ? p : -1e30f; s[it] = p; m = fmaxf(m, p);
    }
    m = fmaxf(m, __shfl_xor(m, 16)); m = fmaxf(m, __shfl_xor(m, 32));
    float den = 0.f; f32x4 acc = {0.f, 0.f, 0.f, 0.f};
#pragma unroll
    for (int it = 0; it < 17; ++it) {
        const int i = i0 + 4 * it + kg; const bool ok = i <= 128; const int idx = LBUF + j - dl * (ok ? i : 128);
        const float* vp = idx >= LBUF ? VS + (size_t)(b * 4 + idx - LBUF) * 512 + h * 64 : cv + (((size_t)b * LBUF + idx) * 8 + h) * 64;
        const f32x4 vv = *(const f32x4*)(vp + 4 * d4);
        const float p = __builtin_amdgcn_exp2f(s[it] - m); den += p; acc = acc + vv * p;
    }
    den += __shfl_xor(den, 16); den += __shfl_xor(den, 32);
#pragma unroll
    for (int e = 0; e < 4; ++e) { acc[e] += __shfl_xor(acc[e], 16); acc[e] += __shfl_xor(acc[e], 32); }
    const float rd = 1.0f / den; const int part = di * 2 + half;
    if (kg == 0) *(f32x4*)(OUS + ((size_t)part * NSAMP + b * 4 + j) * 512 + h * 64 + 4 * d4) = acc * rd;
    if (lane == 0) LSES[((size_t)part * NSAMP + b * 4 + j) * 8 + h] = m + __builtin_amdgcn_logf(den);
}
__device__ __forceinline__ void samp_gmlp_task(int b, int lane, const float* VCS, const float* US, const float* lng, const float* lnb, const float* ws, const float* bs, float* outvc, bf16_t* MIX) {
    const int ch = 8 * lane, g = lane >> 3;
    const f32x4 g0 = *(const f32x4*)(lng + ch), g1 = *(const f32x4*)(lng + ch + 4), b0 = *(const f32x4*)(lnb + ch), b1 = *(const f32x4*)(lnb + ch + 4);
    f32x4 vn[4][2];
#pragma unroll
    for (int j = 0; j < 4; ++j) {
        f32x4 x0 = *(const f32x4*)(VCS + (size_t)(b * 4 + j) * 512 + ch), x1 = *(const f32x4*)(VCS + (size_t)(b * 4 + j) * 512 + ch + 4);
        const float mean = wave_sum(((x0[0] + x0[1]) + (x0[2] + x0[3])) + ((x1[0] + x1[1]) + (x1[2] + x1[3]))) * (1.0f / 512.0f);
        x0 = x0 - mean; x1 = x1 - mean;
        const float var = wave_sum(((x0[0] * x0[0] + x0[1] * x0[1]) + (x0[2] * x0[2] + x0[3] * x0[3])) + ((x1[0] * x1[0] + x1[1] * x1[1]) + (x1[2] * x1[2] + x1[3] * x1[3]))) * (1.0f / 512.0f);
        const float rstd = 1.0f / sqrtf(var + EPS);
        x0 = x0 * rstd * g0 + b0; x1 = x1 * rstd * g1 + b1; vn[j][0] = x0; vn[j][1] = x1;
        *(f32x4*)(outvc + (size_t)(b * 4 + j) * 512 + ch) = x0; *(f32x4*)(outvc + (size_t)(b * 4 + j) * 512 + ch + 4) = x1;
    }
#pragma unroll
    for (int i = 0; i < 4; ++i) {
        const float bias = bs[g * 128 + i]; f32x4 m0 = {bias, bias, bias, bias}, m1 = m0;
#pragma unroll
        for (int j = 0; j <= i; ++j) { const float wv = ws[((size_t)g * 128 + i) * 128 + j]; m0 = m0 + vn[j][0] * wv; m1 = m1 + vn[j][1] * wv; }
        const f32x4 u0 = *(const f32x4*)(US + (size_t)(b * 4 + i) * 512 + ch), u1 = *(const f32x4*)(US + (size_t)(b * 4 + i) * 512 + ch + 4);
        *(u32x4*)(MIX + (size_t)(SEQ + b * 4 + i) * 1024 + 512 + ch) = pack8(u0 * m0, u1 * m1);
    }
}
template <int SPLIT, class F>
__device__ __forceinline__ void small_gemm(LAS unsigned char* lds, const bf16_t* A, const bf16_t* Bt, int K, int N, int bx, int G, int wave, int lane, const F& f) {
    constexpr int TPB = NWAVES / SPLIT;
    const int fr = lane & 15, fq = lane >> 4, ntiles = 8 * (N >> 4), ks = wave & (SPLIT - 1), tl = wave / SPLIT, kchunk = K / SPLIT;
    LAS f32x4* red = (LAS f32x4*)lds;
    for (int t0 = bx * TPB; t0 < ntiles; t0 += G * TPB) {
        const int t = t0 + tl, mt = t & 7, nt = t >> 3;
        const bf16_t* ap = A + (size_t)(mt * 16 + fr) * K + fq * 8 + ks * kchunk; const bf16_t* bp = Bt + (size_t)(nt * 16 + fr) * K + fq * 8 + ks * kchunk;
        f32x4 acc = {0.f, 0.f, 0.f, 0.f};
        bf16x8 a0[8], b0[8], a1[8], b1[8];
#define SG_LOAD(a, b, k) do { _Pragma("unroll") for (int i_ = 0; i_ < 8; ++i_) { a[i_] = *(const bf16x8*)(ap + (k) + 32 * i_); b[i_] = *(const bf16x8*)(bp + (k) + 32 * i_); } } while (0)
#define SG_MMA(a, b) do { _Pragma("unroll") for (int i_ = 0; i_ < 8; ++i_) acc = __builtin_amdgcn_mfma_f32_16x16x32_bf16(a[i_], b[i_], acc, 0, 0, 0); } while (0)
        SG_LOAD(a0, b0, 0);
#pragma unroll 1
        for (int k = 0; k < kchunk; k += 512) {
            const bool m1 = k + 256 < kchunk, m2 = k + 512 < kchunk;
            if (m1) SG_LOAD(a1, b1, k + 256);
            SG_MMA(a0, b0);
            if (m1) { if (m2) SG_LOAD(a0, b0, k + 512); SG_MMA(a1, b1); }
        }
#undef SG_LOAD
#undef SG_MMA
        if (SPLIT > 1) {
            __syncthreads();
            if (ks) red[wave * 64 + lane] = acc;
            __syncthreads();
            if (ks == 0) {
#pragma unroll
                for (int s_ = 1; s_ < SPLIT; ++s_) acc = acc + red[(wave + s_) * 64 + lane];
                f(mt * 16 + 4 * fq, nt * 16 + fr, nt, acc);
            }
        } else f(mt * 16 + 4 * fq, nt * 16 + fr, nt, acc);
    }
}
template <int SPLIT, class F>
__device__ __forceinline__ void small_gemm_w64(LAS unsigned char* lds, const bf16_t* A, const bf16_t* Bt, int K, int N, int bx, int G, int wave, int lane, const F& f) {
    constexpr int TPB = NWAVES / SPLIT;
    const int fr = lane & 15, fq = lane >> 4, ngroups = 8 * (N >> 6), ks = wave & (SPLIT - 1), tl = wave / SPLIT, kchunk = K / SPLIT;
    LAS f32x4* red = (LAS f32x4*)lds;
    for (int t0 = bx * TPB; t0 < ngroups; t0 += G * TPB) {
        const int t = t0 + tl, mt = t & 7, ng = t >> 3;
        const bf16_t* ap = A + (size_t)(mt * 16 + fr) * K + fq * 8 + ks * kchunk; const bf16_t* bp = Bt + (size_t)(ng * 64 + fr) * K + fq * 8 + ks * kchunk;
        f32x4 acc[4]; acc[0] = (f32x4){0.f, 0.f, 0.f, 0.f}; acc[1] = acc[0]; acc[2] = acc[0]; acc[3] = acc[0];
        bf16x8 a0[4], b0[4][4], a1[4], b1[4][4];
#define SGW_LOAD(a, b, k) do { _Pragma("unroll") for (int i_ = 0; i_ < 4; ++i_) { a[i_] = *(const bf16x8*)(ap + (k) + 32 * i_); _Pragma("unroll") for (int j_ = 0; j_ < 4; ++j_) b[i_][j_] = *(const bf16x8*)(bp + (size_t)(16 * j_) * K + (k) + 32 * i_); } } while (0)
#define SGW_MMA(a, b) do { _Pragma("unroll") for (int i_ = 0; i_ < 4; ++i_) _Pragma("unroll") for (int j_ = 0; j_ < 4; ++j_) acc[j_] = __builtin_amdgcn_mfma_f32_16x16x32_bf16(a[i_], b[i_][j_], acc[j_], 0, 0, 0); } while (0)
        SGW_LOAD(a0, b0, 0);
#pragma unroll 1
        for (int k = 0; k < kchunk; k += 256) {
            const bool m1 = k + 128 < kchunk, m2 = k + 256 < kchunk;
            if (m1) SGW_LOAD(a1, b1, k + 128);
            SGW_MMA(a0, b0);
            if (m1) { if (m2) SGW_LOAD(a0, b0, k + 256); SGW_MMA(a1, b1); }
        }
#undef SGW_LOAD
#undef SGW_MMA
        if (SPLIT > 1) {
            __syncthreads();
            if (ks) {
#pragma unroll
                for (int j = 0; j < 4; ++j) red[(wave * 4 + j) * 64 + lane] = acc[j]; }
            __syncthreads();
            if (ks == 0) {
#pragma unroll
                for (int s_ = 1; s_ < SPLIT; ++s_)
#pragma unroll
                    for (int j = 0; j < 4; ++j) acc[j] = acc[j] + red[((wave + s_) * 4 + j) * 64 + lane];
            }
        }
        if (ks == 0) {
#pragma unroll
            for (int j = 0; j < 4; ++j) f(mt * 16 + 4 * fq, ng * 64 + j * 16 + fr, ng * 4 + j, acc[j]);
        }
    }
}
__device__ __forceinline__ float rstd_from_slots64(const float* p, int fr) {
    const f32x4 a = *(const f32x4*)(p + 4 * fr); return 1.0f / sqrtf(red16((a[0] + a[1]) + (a[2] + a[3])) * (1.0f / 1024.0f) + EPS);
}

__device__ __forceinline__ unsigned f2bf(float f) { unsigned u = __builtin_bit_cast(unsigned, f); return (u + 0x7fffu + ((u >> 16) & 1u)) >> 16; }
__device__ __forceinline__ unsigned pk2(float lo, float hi) { return f2bf(lo) | (f2bf(hi) << 16); }
struct TrItem { const float* W; bf16_t* WT; const float* gain; int K, N, k0, n0; };
__device__ __forceinline__ void p0_tr_load(const TrItem& it, float (&tv)[32], int lane) {
#pragma unroll
    for (int i = 0; i < 32; ++i) { const int kk = 2 * i + (lane >> 5); tv[i] = it.W[(size_t)(it.k0 + kk) * it.N + it.n0 + (lane & 31)]; }
}
__device__ __forceinline__ void p0_tr_store(const TrItem& it, float (&tv)[32], LAS float* scr, int lane) {
    if (it.gain) {
#pragma unroll
        for (int i = 0; i < 32; ++i) tv[i] *= it.gain[it.k0 + 2 * i + (lane >> 5)]; }
#pragma unroll
    for (int i = 0; i < 32; ++i) scr[(2 * i + (lane >> 5)) * 33 + (lane & 31)] = tv[i];
    asm volatile("s_waitcnt lgkmcnt(0)" ::: "memory");
    const int c = lane & 7;
#pragma unroll
    for (int j = 0; j < 4; ++j) { const int n = (lane >> 3) + 8 * j; const LAS float* sp = scr + (8 * c) * 33 + n;
        u32x4 o; o.x = pk2(sp[0 * 33], sp[1 * 33]); o.y = pk2(sp[2 * 33], sp[3 * 33]); o.z = pk2(sp[4 * 33], sp[5 * 33]); o.w = pk2(sp[6 * 33], sp[7 * 33]);
        *(u32x4*)(it.WT + (size_t)(it.n0 + n) * it.K + it.k0 + 8 * c) = o; }
    asm volatile("s_waitcnt lgkmcnt(0)" ::: "memory");
}
__device__ __forceinline__ void sincos_d(double a, float& s, float& c) {
    const double k = rint(a * 0.6366197723675814);
    const double r = fma(-k, 6.123233995736766e-17, fma(-k, 1.5707963267948966, a)), r2 = r * r;
    const double sp = r * (1.0 + r2 * (-1.0 / 6 + r2 * (1.0 / 120 + r2 * (-1.0 / 5040 + r2 * (1.0 / 362880 + r2 * (-1.0 / 39916800 + r2 * (1.0 / 6227020800.0)))))));
    const double cp = 1.0 + r2 * (-0.5 + r2 * (1.0 / 24 + r2 * (-1.0 / 720 + r2 * (1.0 / 40320 + r2 * (-1.0 / 3628800 + r2 * (1.0 / 479001600 + r2 * (-1.0 / 87178291200.0)))))));
    const int qd = (int)k & 3;
    const double sv = qd == 0 ? sp : qd == 1 ? cp : qd == 2 ? -sp : -cp, cv = qd == 0 ? cp : qd == 1 ? -sp : qd == 2 ? -cp : sp;
    s = (float)sv; c = (float)cv;
}
#define XB_TMO      128
#define XB_XCNT(j)  (256  + 64 * (j))
#define XB_XSUB(j)  (1280 + 64 * (j))
#define XB_XGEN(j)  (2304 + 64 * (j))
#define XB_TOP      3328
#define XB_TOPGEN   3392
#define XCD_BAR_WORDS 3456
#define XB_SPIN_CAP (1u << 18)

__device__ __forceinline__ unsigned xb_ld(unsigned* p)              { return __hip_atomic_load(p, __ATOMIC_RELAXED, __HIP_MEMORY_SCOPE_AGENT); }
__device__ __forceinline__ unsigned xb_add(unsigned* p, unsigned v) { return __hip_atomic_fetch_add(p, v, __ATOMIC_RELAXED, __HIP_MEMORY_SCOPE_AGENT); }
__device__ __forceinline__ unsigned xb_xcc_id() { return (unsigned)__builtin_amdgcn_s_getreg((3 << 11) | 20) & 0xFu; }
#define XB_SPIN(cond, bar) do { unsigned _sp = 0; while (cond) { __builtin_amdgcn_s_sleep(1); \
    if ((++_sp & 255u) == 0u) { if (xb_ld(&(bar)[XB_TMO])) break; if (_sp > XB_SPIN_CAP) { atomicAdd(&(bar)[XB_TMO], 1u); break; } } } } while (0)

struct XcdBarrier {
    unsigned* bar; unsigned x;
    volatile LAS unsigned* st;
};

__device__ __forceinline__ XcdBarrier xcd_barrier_post(unsigned* bar, volatile LAS unsigned* st) {
    XcdBarrier b; b.bar = bar; b.x = xb_xcc_id(); b.st = st;
    if (threadIdx.x == 0) (void)xb_add(&bar[XB_XCNT(b.x)], 1u);
    return b;
}
__device__ __forceinline__ void xcd_barrier_complete(unsigned* bar, unsigned x, unsigned& nloc, unsigned& nx) {
    const unsigned G = gridDim.x * gridDim.y * gridDim.z;
    unsigned sum, cnt, mine, sp = 0u;
    for (;;) {
        sum = 0u; cnt = 0u; mine = 0u;
#pragma unroll
        for (unsigned j = 0; j < 16; ++j) { const unsigned c = xb_ld(&bar[XB_XCNT(j)]); sum += c; cnt += (c > 0u) ? 1u : 0u; mine = (j == x) ? c : mine; }
        if (sum == G) break;
        __builtin_amdgcn_s_sleep(1);
        if ((++sp & 255u) == 0u) { if (xb_ld(&bar[XB_TMO])) break; if (sp > XB_SPIN_CAP) { atomicAdd(&bar[XB_TMO], 1u); break; } }
    }
    nloc = mine > 0u ? mine : 1u; nx = cnt > 0u ? cnt : 1u;
}

__device__ __forceinline__ void xcd_barrier(const XcdBarrier& b) {
    asm volatile("s_waitcnt vmcnt(0)" ::: "memory");
    __syncthreads();
    if (threadIdx.x == 0) {
        unsigned* bar = b.bar;
        __builtin_amdgcn_s_waitcnt(0);
        unsigned nloc = b.st[0], nx = b.st[1];
        if (nloc == 0u) { xcd_barrier_complete(bar, b.x, nloc, nx); b.st[0] = nloc; b.st[1] = nx; }
        const unsigned old = xb_add(&bar[XB_XSUB(b.x)], 1u);
        const unsigned gen = old / nloc;
        if (old + 1u == (gen + 1u) * nloc) {
            __builtin_amdgcn_fence(__ATOMIC_RELEASE, "agent");
            asm volatile("s_waitcnt vmcnt(0)" ::: "memory");
            const unsigned og = xb_add(&bar[XB_TOP], 1u);
            const unsigned tg = og / nx;
            if (og + 1u == (tg + 1u) * nx) xb_add(&bar[XB_TOPGEN], 1u);
            else XB_SPIN(xb_ld(&bar[XB_TOPGEN]) == tg, bar);
            __builtin_amdgcn_fence(__ATOMIC_ACQUIRE, "agent");
            xb_add(&bar[XB_XGEN(b.x)], 1u);
            asm volatile("s_waitcnt vmcnt(0)" ::: "memory");
        } else {
            XB_SPIN(xb_ld(&bar[XB_XGEN(b.x)]) == gen, bar);
            __builtin_amdgcn_fence(__ATOMIC_ACQUIRE, "agent");
            asm volatile("s_waitcnt vmcnt(0)" ::: "memory");
        }
    }
    __syncthreads();
}

constexpr size_t MiB = 1u << 20;
constexpr size_t WS_WIN = 1 * MiB, WS_WOUT = 6 * MiB, WS_WUP = 8 * MiB, WS_WDOWN = 16 * MiB, WS_WGATE = 24 * MiB, WS_WPLE = 26 * MiB, WS_WSB = 27 * MiB, WS_ROPE = 28 * MiB;
constexpr size_t WS_SMALL = 30 * MiB, WS_SSQ = 32 * MiB, WS_LSE = 35 * MiB, WS_PB = 38 * MiB, WS_ACT = 48 * MiB, WS_H1 = 82 * MiB, WS_PLEB = 148 * MiB, WS_MIX = 182 * MiB, WS_BIG = 216 * MiB, WS_END = 346 * MiB;
constexpr size_t OUT_KP = (size_t)MTOT * DM, OUT_VP = OUT_KP + 2048 * 512, OUT_KS = OUT_VP + 2048 * 512, OUT_VS = OUT_KS + NSAMP * 512, OUT_VC = OUT_VS + NSAMP * 512, OUT_END = OUT_VC + NSAMP * 512;
constexpr int LDS_BYTES = 147456;
constexpr int NPH = 9;

struct PleOrder {
    int c, G;
    __device__ bool next(int i, pg8::Unit& u) const {
        const int half = G >> 1, L = (G == 256) ? i * half + (c - half) : i * G + c;
        if (L >= 256 || (G == 256 && c < half)) return false;
        u.pm = L >> 2; u.pn = L & 3; return true;
    }
    __device__ __forceinline__ void a_ready(const pg8::Unit&) const {}
    __device__ __forceinline__ void done(const pg8::Unit&) const {}
};

struct Args { const float* in[20]; float* out; unsigned char* ws; int ph_lo, ph_hi; };

template <int MASK>
__global__ void __launch_bounds__(NWAVES * 64, 2) hymba_fwd(Args args) {
    extern __shared__ __attribute__((aligned(16))) unsigned char lds_raw[];
    LAS unsigned char* lds = (LAS unsigned char*)lds_raw;
    cg::grid_group grid = cg::this_grid();
    if (threadIdx.x < 2) ((volatile LAS unsigned*)(lds + 131072))[threadIdx.x] = 0u;
    __syncthreads();
    const XcdBarrier bar = xcd_barrier_post((unsigned*)(*(unsigned char* const __attribute__((address_space(4)))*)((__attribute__((address_space(4))) const unsigned char*)__builtin_amdgcn_kernarg_segment_ptr() + 168)), (volatile LAS unsigned*)(lds + 131072));
    const int tid = threadIdx.x, lane = tid & 63, wave = __builtin_amdgcn_readfirstlane(tid >> 6);
    const int G = gridDim.x, bx = blockIdx.x, gw = bx * NWAVES + wave, NGW = G * NWAVES;
    typedef __attribute__((address_space(4))) const unsigned char* kptr_t;
    const kptr_t kbase = (kptr_t)__builtin_amdgcn_kernarg_segment_ptr();
#define LDP(T, off) (*(T const volatile __attribute__((address_space(4)))*)(kbase + (off)))
#define P_IN(i) LDP(const float*, 8 * (i))
#define DECL_WS unsigned char* const ws = LDP(unsigned char*, 168); float* const out = LDP(float*, 160); (void)out; (void)ws;
#define xp P_IN(0)
#define xs P_IN(1)
#define ck P_IN(2)
#define cv P_IN(3)
#define pp P_IN(4)
#define ps P_IN(5)
#define n1g P_IN(6)
#define w_in P_IN(7)
#define lng P_IN(8)
#define lnb P_IN(9)
#define wsp P_IN(10)
#define bsp P_IN(11)
#define w_out P_IN(12)
#define n2g P_IN(13)
#define w_up P_IN(14)
#define w_down P_IN(15)
#define gng P_IN(16)
#define w_gate P_IN(17)
#define w_ple P_IN(18)
#define fg P_IN(19)
#define WIN ((bf16_t*)(ws + WS_WIN))
#define WOUT ((bf16_t*)(ws + WS_WOUT))
#define WUP ((bf16_t*)(ws + WS_WUP))
#define WDOWN ((bf16_t*)(ws + WS_WDOWN))
#define WGATE ((bf16_t*)(ws + WS_WGATE))
#define WPLE ((bf16_t*)(ws + WS_WPLE))
#define WSB ((bf16_t*)(ws + WS_WSB))
#define ROPE ((float*)(ws + WS_ROPE))
#define QS ((float*)(ws + WS_SMALL))
#define KS (QS + NSAMP * 512)
#define VS (QS + 2 * NSAMP * 512)
#define US (QS + 3 * NSAMP * 512)
#define VCS (QS + 4 * NSAMP * 512)
#define SSQS1 (QS + 5 * NSAMP * 512)
#define SSQS2 (SSQS1 + NSAMP * 64)
#define SSQS3 (SSQS1 + 2 * NSAMP * 64)
#define SSQ1 ((float*)(ws + WS_SSQ))
#define SSQ2 (SSQ1 + SEQ * 16)
#define SSQ3 (SSQ1 + 2 * SEQ * 16)
#define LSE ((float*)(ws + WS_LSE))
#define OUS ((float*)(ws + WS_H1))
#define LSES (OUS + 6 * NSAMP * 512)
#define PB ((bf16_t*)(ws + WS_PB))
#define ACT ((bf16_t*)(ws + WS_ACT))
#define PLEB ((bf16_t*)(ws + WS_PLEB))
#define MIX ((bf16_t*)(ws + WS_MIX))
#define H1 ((float*)(ws + WS_H1))
#define Qb ((bf16_t*)(ws + WS_BIG))
#define Kb (Qb + (size_t)SEQ * 512)
#define Vb (Qb + (size_t)2 * SEQ * 512)
#define Ub (Qb + (size_t)3 * SEQ * 512)
#define VCb (Qb + (size_t)4 * SEQ * 512)
#define OU (Qb + (size_t)5 * SEQ * 512)
#define HID ((bf16_t*)(ws + WS_BIG))
    const int lo = args.ph_lo, hi = args.ph_hi;
#define IN(k) ((((MASK) >> (k)) & 1) && lo <= (k) && (k) < hi)
#define SEAM(k) do { if (IN(k) && IN((k) + 1)) xcd_barrier(bar); } while (0)
    if (lo > 1000) grid.sync();

    if (IN(0)) { DECL_WS
        LAS float* scr = (LAS float*)(lds + wave * 16384);
        constexpr int I_IN = 16 * 80, I_OUT = 16 * 32, I_UP = 16 * 128, I_DOWN = 64 * 32, I_GATE = 16 * 32, I_PLE = 4 * 32, NITEMS = I_IN + I_OUT + I_UP + I_DOWN + I_GATE + I_PLE;
        { const float* const w_in_ = w_in; const float* const w_out_ = w_out; const float* const w_up_ = w_up; const float* const w_down_ = w_down; const float* const w_gate_ = w_gate; const float* const w_ple_ = w_ple;
          const float* const n2g_ = n2g; const float* const gng_ = gng;
          auto mk = [&](int it) { TrItem t; int r = it;
              if (r < I_IN) { t.W = w_in_; t.WT = WIN; t.gain = nullptr; t.K = DM; t.N = INW; }
              else if ((r -= I_IN) < I_OUT) { t.W = w_out_; t.WT = WOUT; t.gain = nullptr; t.K = DM; t.N = DM; }
              else if ((r -= I_OUT) < I_UP) { t.W = w_up_; t.WT = WUP; t.gain = n2g_; t.K = DM; t.N = DFF; }
              else if ((r -= I_UP) < I_DOWN) { t.W = w_down_; t.WT = WDOWN; t.gain = nullptr; t.K = DFF; t.N = DM; }
              else if ((r -= I_DOWN) < I_GATE) { t.W = w_gate_; t.WT = WGATE; t.gain = gng_; t.K = DM; t.N = DM; }
              else { r -= I_GATE; t.W = w_ple_; t.WT = WPLE; t.gain = nullptr; t.K = PLE; t.N = DM; }
              const int nblk = t.N / 32; t.k0 = 64 * (r / nblk); t.n0 = 32 * (r % nblk); return t; };
          float tva[32], tvb[32];
          int it = gw;
          if (it < NITEMS) { TrItem ca = mk(it); p0_tr_load(ca, tva, lane);
              for (;;) {
                  const int itb = it + NGW; const bool hb = itb < NITEMS; TrItem cb = ca; if (hb) { cb = mk(itb); p0_tr_load(cb, tvb, lane); }
                  p0_tr_store(ca, tva, scr, lane);
                  if (!hb) break;
                  const int itc = itb + NGW; const bool hc = itc < NITEMS; if (hc) { ca = mk(itc); p0_tr_load(ca, tva, lane); }
                  p0_tr_store(cb, tvb, scr, lane);
                  if (!hc) break;
                  it = itc;
              } }
        }
        { const float* const xp_ = xp; const float* const xs_ = xs; const float* const pp_ = pp; const float* const ps_ = ps; const float* const n1g_ = n1g;
          f32x4 gg[4];
#pragma unroll
          for (int j = 0; j < 4; ++j) gg[j] = ((const f32x4*)n1g_)[64 * j + lane];
          for (int m0 = gw; m0 < MTOT; m0 += 8 * NGW) {
            f32x4 v[8][4]; f32x4 pv[8]; float ssq[8];
#pragma unroll
            for (int r = 0; r < 8; ++r) { const int m = m0 + r * NGW; const bool ok = m < MTOT; const int mm = ok ? m : 0;
                const float* src = mm < SEQ ? xp_ + (size_t)mm * DM : xs_ + (size_t)(mm - SEQ) * DM;
                const float* psrc = mm < SEQ ? pp_ + (size_t)mm * PLE : ps_ + (size_t)(mm - SEQ) * PLE;
#pragma unroll
                for (int j = 0; j < 4; ++j) v[r][j] = ((const f32x4*)src)[64 * j + lane];
                pv[r] = ((const f32x4*)psrc)[lane]; }
#pragma unroll
            for (int r = 0; r < 8; ++r) { float sacc = 0.f;
#pragma unroll
                for (int j = 0; j < 4; ++j) sacc += (v[r][j][0] * v[r][j][0] + v[r][j][1] * v[r][j][1]) + (v[r][j][2] * v[r][j][2] + v[r][j][3] * v[r][j][3]);
                ssq[r] = sacc; }
#pragma unroll
            for (int o = 1; o < 64; o <<= 1) {
#pragma unroll
                for (int r = 0; r < 8; ++r) ssq[r] += __shfl_xor(ssq[r], o); }
#pragma unroll
            for (int r = 0; r < 8; ++r) { const int m = m0 + r * NGW; if (m < MTOT) { const float rstd = 1.0f / sqrtf(ssq[r] * (1.0f / DM) + EPS);
#pragma unroll
                for (int j = 0; j < 4; ++j) *(u32x2*)(ACT + (size_t)m * DM + 256 * j + 4 * lane) = pack4(v[r][j] * rstd * gg[j]);
                *(u32x2*)(PB + (size_t)m * PLE + 4 * lane) = pack4(pv[r]); } }
          } }
        for (int idx = bx * 512 + tid; idx < (SEQ + 4) * 8; idx += G * 512) {
            const int pos = idx >> 3, i = idx & 7;
            const float invf = i == 0 ? 1.0f : i == 1 ? 0.1939227432012558f : i == 2 ? 0.03760603070259094f : i == 3 ? 0.007292664609849453f : i == 4 ? 0.0014142135623842478f : i == 5 ? 0.00027424818836152554f : i == 6 ? 5.3182957344688475e-05f : 1.0313385246263351e-05f;
            const float ang = (float)pos * invf; float s, c; sincos_d((double)ang, s, c);
            ROPE[(size_t)pos * 16 + i] = c; ROPE[(size_t)pos * 16 + 8 + i] = s;
        }
        for (int idx = bx * 512 + tid; idx < 8 * 128 * 128; idx += G * 512) { const int i = (idx >> 7) & 127, j = idx & 127; WSB[idx] = (bf16_t)f2bf(j <= i ? wsp[idx] : 0.f); }
    }
    SEAM(0);
    if (IN(1)) { DECL_WS
        { pg8::Gemm g{ACT, WIN, SEQ, INW, DM}; pg8::StaticOrder S; S.init(SEQ, INW, G, bx);
          pg8::EpiIn E{Qb, Kb, Vb, Ub, VCb, ROPE, out + OUT_KP, out + OUT_VP};
          pg8::gemm_phase<pg8::EpiIn, pg8::StaticOrder, true, true>(lds, g, S, E); }
        { int kple = PLE; asm volatile("" : "+s"(kple));
          pg8::Gemm g{PB, WPLE, SEQ, DM, kple}; PleOrder S{bx, G}; pg8::EpiBf E{PLEB};
          pg8::gemm_phase<pg8::EpiBf, PleOrder, true, true>(lds, g, S, E); }
        float* oks = out + OUT_KS; float* ovs = out + OUT_VS;
        const int sG = (G == 256) ? 64 : G, sbx = (G == 256) ? (bx >= 192 ? bx - 192 : 1 << 20) : bx;
        const int aG = (G == 256) ? 128 : G, abx = (G == 256) ? (bx >= 128 ? bx - 128 : 1 << 20) : bx;
        small_gemm_w64<4>(lds, ACT + (size_t)SEQ * DM, WIN, DM, INW, abx, aG, wave, lane, [=](int rb, int col, int nt, f32x4 acc) {
            const int seg = col >> 9, lc = col & 511, fr = col & 15; const bool rp = seg < 2 && (nt & 3) == 0;
#pragma unroll
            for (int i = 0; i < 4; ++i) { const int row = rb + i; float v = acc[i];
                if (rp) { const float p = __shfl_xor(v, 8); const float* r = ROPE + (size_t)(SEQ + (row & 3)) * 16 + (fr & 7); const float c = r[0], s = r[8]; v = fr < 8 ? v * c - p * s : v * c + p * s; }
                const size_t o = (size_t)row * 512 + lc;
                if (seg == 0) QS[o] = v * QSCALE; else if (seg == 1) { KS[o] = v; oks[o] = v; } else if (seg == 2) { VS[o] = v; ovs[o] = v; } else if (seg == 3) US[o] = pg8::gelu_tanh(v); else VCS[o] = pg8::gelu_tanh(v); } });
        small_gemm<1>(lds, PB + (size_t)SEQ * PLE, WPLE, PLE, DM, sbx, sG, wave, lane, [=](int rb, int col, int nt, f32x4 acc) {
#pragma unroll
            for (int i = 0; i < 4; ++i) PLEB[(size_t)(SEQ + rb + i) * DM + col] = (bf16_t)f2bf(acc[i]); });
    }
    SEAM(1);
    if (IN(2)) { DECL_WS
        const bool mem_first = (bx & 8) != 0;
        if (mem_first) {
            for (int t = gw; t < 6144 + 32; t += NGW) { if (t < 6144) samp_attn_task(t, lane, QS, KS, VS, ck, cv, OUS, LSES); else samp_gmlp_task(t - 6144, lane, VCS, US, lng, lnb, wsp, bsp, out + OUT_VC, MIX); }
            for (int c = bx; c < 256; c += G) gmlp_unit(lds, c, VCb, Ub, lng, lnb, WSB, bsp, MIX);
        }
        { AttnPre P; if (bx < 3 * 64 * 8) attn_prefetch(P, bx, Kb, Vb);
          for (int a = bx; a < 3 * 64 * 8; a += G) attn_unit(lds, a, a + G, a + G < 3 * 64 * 8, P, Qb, Kb, Vb, OU, LSE); }
        if (!mem_first) {
            for (int c = bx; c < 256; c += G) gmlp_unit(lds, c, VCb, Ub, lng, lnb, WSB, bsp, MIX);
            for (int t = gw; t < 6144 + 32; t += NGW) { if (t < 6144) samp_attn_task(t, lane, QS, KS, VS, ck, cv, OUS, LSES); else samp_gmlp_task(t - 6144, lane, VCS, US, lng, lnb, wsp, bsp, out + OUT_VC, MIX); }
        }
    }
    SEAM(2);
    if (IN(3)) { DECL_WS
        for (int idx = bx * 512 + tid; idx < SEQ * 64; idx += G * 512) {
            const int tok = idx >> 6, hd = (idx >> 3) & 7, chk = idx & 7;
            const float l0 = LSE[(size_t)tok * 8 + hd], l1 = LSE[((size_t)SEQ + tok) * 8 + hd], l2 = LSE[((size_t)2 * SEQ + tok) * 8 + hd];
            const float mx = fmaxf(l0, fmaxf(l1, l2)); float w0 = __builtin_amdgcn_exp2f(l0 - mx), w1 = __builtin_amdgcn_exp2f(l1 - mx), w2 = __builtin_amdgcn_exp2f(l2 - mx);
            const float rw = 1.0f / (w0 + w1 + w2); w0 *= rw; w1 *= rw; w2 *= rw;
            const size_t o = (size_t)tok * 512 + hd * 64 + chk * 8;
            const u32x4 a = *(const u32x4*)(OU + o), b = *(const u32x4*)(OU + (size_t)SEQ * 512 + o), c = *(const u32x4*)(OU + (size_t)2 * SEQ * 512 + o);
            u32x4 r;
#pragma unroll
            for (int e = 0; e < 4; ++e) { const float lo_ = __uint_as_float(a[e] << 16) * w0 + __uint_as_float(b[e] << 16) * w1 + __uint_as_float(c[e] << 16) * w2;
                const float hi_ = __uint_as_float(a[e] & 0xffff0000u) * w0 + __uint_as_float(b[e] & 0xffff0000u) * w1 + __uint_as_float(c[e] & 0xffff0000u) * w2; r[e] = cvt_pk_bf16(lo_, hi_); }
            *(u32x4*)(MIX + (size_t)tok * 1024 + hd * 64 + chk * 8) = r;
        }
        for (int idx = bx * 512 + tid; idx < NSAMP * 64; idx += G * 512) {
            const int tok = idx >> 6, hd = (idx >> 3) & 7, chk = idx & 7;
            float l[6], mx = -1e30f;
#pragma unroll
            for (int p = 0; p < 6; ++p) { l[p] = LSES[((size_t)p * NSAMP + tok) * 8 + hd]; mx = fmaxf(mx, l[p]); }
            float wsum = 0.f;
#pragma unroll
            for (int p = 0; p < 6; ++p) { l[p] = __builtin_amdgcn_exp2f(l[p] - mx); wsum += l[p]; }
            const float rw = 1.0f / wsum; const size_t o = (size_t)tok * 512 + hd * 64 + chk * 8;
            f32x4 a0 = {0.f, 0.f, 0.f, 0.f}, a1 = a0;
#pragma unroll
            for (int p = 0; p < 6; ++p) { const float w = l[p] * rw; a0 = a0 + *(const f32x4*)(OUS + (size_t)p * NSAMP * 512 + o) * w; a1 = a1 + *(const f32x4*)(OUS + (size_t)p * NSAMP * 512 + o + 4) * w; }
            *(u32x4*)(MIX + (size_t)(SEQ + tok) * 1024 + hd * 64 + chk * 8) = pack8(a0, a1);
        }
    }
    SEAM(3);
    if (IN(4)) { DECL_WS
        { pg8::Gemm g{MIX, WOUT, SEQ, DM, DM}; pg8::StaticOrder S; S.init(SEQ, DM, G, bx); pg8::EpiRes<true> E{xp, ACT, SSQ1};
          pg8::gemm_phase<pg8::EpiRes<true>, pg8::StaticOrder, false, true>(lds, g, S, E); }
        small_gemm<4>(lds, MIX + (size_t)SEQ * DM, WOUT, DM, DM, bx, G, wave, lane, [=](int rb, int col, int nt, f32x4 acc) {
#pragma unroll
            for (int i = 0; i < 4; ++i) { const int row = rb + i; const bf16_t hb = (bf16_t)f2bf(xs[(size_t)row * DM + col] + acc[i]); const float h = pg8::bf2f(hb); ACT[(size_t)(SEQ + row) * DM + col] = hb;
                const float s = red16(h * h); if ((col & 15) == 0) SSQS1[row * 64 + nt] = s; } });
    }
    SEAM(4);
    if (IN(5)) { DECL_WS
        { pg8::Gemm g{ACT, WUP, SEQ, DFF, DM}; pg8::StaticOrder S; S.init(SEQ, DFF, G, bx); pg8::EpiUp E{HID, SSQ1};
          pg8::gemm_phase<pg8::EpiUp, pg8::StaticOrder, true, true>(lds, g, S, E); }
        small_gemm_w64<4>(lds, ACT + (size_t)SEQ * DM, WUP, DM, DFF, bx, G, wave, lane, [=](int rb, int col, int nt, f32x4 acc) {
#pragma unroll
            for (int i = 0; i < 4; ++i) { const int row = rb + i; const float rs = rstd_from_slots64(SSQS1 + row * 64, col & 15); float v = fmaxf(acc[i] * rs, 0.f); HID[(size_t)(SEQ + row) * DFF + col] = (bf16_t)f2bf(v * v); } });
    }
    SEAM(5);
    if (IN(6)) { DECL_WS
        { pg8::Gemm g{HID, WDOWN, SEQ, DM, DFF}; pg8::StaticOrder S; S.init(SEQ, DM, G, bx); pg8::EpiRes<false> E{ACT, ACT, SSQ2};
          pg8::gemm_phase<pg8::EpiRes<false>, pg8::StaticOrder, false, true>(lds, g, S, E); }
        small_gemm<4>(lds, HID + (size_t)SEQ * DFF, WDOWN, DFF, DM, bx, G, wave, lane, [=](int rb, int col, int nt, f32x4 acc) {
#pragma unroll
            for (int i = 0; i < 4; ++i) { const int row = rb + i; const bf16_t hb = (bf16_t)f2bf(pg8::bf2f(ACT[(size_t)(SEQ + row) * DM + col]) + acc[i]); const float h = pg8::bf2f(hb); ACT[(size_t)(SEQ + row) * DM + col] = hb;
                const float s = red16(h * h); if ((col & 15) == 0) SSQS2[row * 64 + nt] = s; } });
    }
    SEAM(6);
    if (IN(7)) { DECL_WS
        { pg8::Gemm g{ACT, WGATE, SEQ, DM, DM}; pg8::StaticOrder S; S.init(SEQ, DM, G, bx); pg8::EpiGateFinal E{ACT, PLEB, SSQ2, fg, out, SSQ3, (unsigned*)ws + 4096};
          pg8::gemm_phase<pg8::EpiGateFinal, pg8::StaticOrder, false, true>(lds, g, S, E); }
        unsigned* cnts = (unsigned*)ws + 4096 + 64 * 64;
        small_gemm<4>(lds, ACT + (size_t)SEQ * DM, WGATE, DM, DM, bx, G, wave, lane, [=](int rb, int col, int nt, f32x4 acc) {
            float y[4];
#pragma unroll
            for (int i = 0; i < 4; ++i) { const int row = rb + i; const size_t o = (size_t)(SEQ + row) * DM + col; const float rs = rstd_from_slots64(SSQS2 + row * 64, col & 15);
                const float gt = __builtin_amdgcn_rcpf(1.0f + __builtin_amdgcn_exp2f(-1.4426950408889634f * acc[i] * rs)); y[i] = pg8::bf2f(ACT[o]) + gt * pg8::bf2f(PLEB[o]);
                const float s = red16(y[i] * y[i]); if ((col & 15) == 0) __hip_atomic_store(SSQS3 + row * 64 + nt, s, __ATOMIC_RELAXED, __HIP_MEMORY_SCOPE_AGENT); }
            const int mt = rb >> 4;
            asm volatile("s_waitcnt vmcnt(0)" ::: "memory");
            if ((col & 15) == 0 && (rb & 15) == 0) __hip_atomic_fetch_add(cnts + 64 * mt, 1u, __ATOMIC_RELAXED, __HIP_MEMORY_SCOPE_AGENT);
            { unsigned spins = 0; while ((unsigned)__builtin_amdgcn_readfirstlane(__hip_atomic_load(cnts + 64 * mt, __ATOMIC_RELAXED, __HIP_MEMORY_SCOPE_AGENT)) < 64u && ++spins < (1u << 22)) __builtin_amdgcn_s_sleep(2); }
            __builtin_amdgcn_fence(__ATOMIC_ACQUIRE, "agent");
            const float gcol = fg[col];
#pragma unroll
            for (int i = 0; i < 4; ++i) { const int row = rb + i; const float* sp = SSQS3 + row * 64 + 4 * (col & 15);
                const float t = (__hip_atomic_load(sp, __ATOMIC_RELAXED, __HIP_MEMORY_SCOPE_AGENT) + __hip_atomic_load(sp + 1, __ATOMIC_RELAXED, __HIP_MEMORY_SCOPE_AGENT)) + (__hip_atomic_load(sp + 2, __ATOMIC_RELAXED, __HIP_MEMORY_SCOPE_AGENT) + __hip_atomic_load(sp + 3, __ATOMIC_RELAXED, __HIP_MEMORY_SCOPE_AGENT));
                out[(size_t)(SEQ + row) * DM + col] = y[i] * (1.0f / sqrtf(red16(t) * (1.0f / 1024.0f) + EPS)) * gcol; }
            });
    }
#undef IN
#undef SEAM
}

extern "C" void kernel_launch(void* const* d_in, const int* in_sizes, int n_in, void* d_out, int out_size, void* d_ws, size_t ws_size, hipStream_t stream) {
    static int grid = 0;
    if (grid == 0) {
        if (n_in != 20 || out_size != (int)OUT_END || ws_size < WS_END) { fprintf(stderr, "kernel_launch: unexpected shapes: n_in %d out %d ws %zu\n", n_in, out_size, ws_size); grid = -1; return; }
        int dev = 0, cus = 0, per_cu = 0;
        (void)hipGetDevice(&dev); (void)hipDeviceGetAttribute(&cus, hipDeviceAttributeMultiprocessorCount, dev);
#if MK_ONE_LAUNCH
        if (hipFuncSetAttribute((const void*)hymba_fwd<MK_MASK>, hipFuncAttributeMaxDynamicSharedMemorySize, LDS_BYTES) != hipSuccess) { fprintf(stderr, "kernel_launch: hipFuncSetAttribute failed\n"); grid = -1; return; }
        if (hipOccupancyMaxActiveBlocksPerMultiprocessor(&per_cu, (const void*)hymba_fwd<MK_MASK>, NWAVES * 64, LDS_BYTES) != hipSuccess || per_cu < 1) { fprintf(stderr, "kernel_launch: occupancy query says %d\n", per_cu); per_cu = 1; }
        (void)hipGetLastError();
#else
        (void)per_cu;
#endif
        grid = cus * 1;
        if (grid <= 0) grid = 256;
    }
    if (grid < 0) return;
    (void)hipMemsetAsync(d_ws, 0, 65536, stream);
    Args a{};
    for (int i = 0; i < 20; ++i) a.in[i] = (const float*)d_in[i];
    a.out = (float*)d_out; a.ws = (unsigned char*)d_ws;
#if MK_ONE_LAUNCH
    a.ph_lo = 0; a.ph_hi = NPH;
    void* kargs[] = {&a};
    hipError_t e = hipLaunchCooperativeKernel((const void*)hymba_fwd<MK_MASK>, dim3(grid), dim3(NWAVES * 64), kargs, LDS_BYTES, stream);
    if (e != hipSuccess) fprintf(stderr, "kernel_launch: cooperative launch failed: %s (grid %d)\n", hipGetErrorString(e), grid);
#else
#define LAUNCH_PH(p) do { a.ph_lo = p; a.ph_hi = p + 1; (void)hipFuncSetAttribute((const void*)hymba_fwd<(1 << p)>, hipFuncAttributeMaxDynamicSharedMemorySize, LDS_BYTES); hipLaunchKernelGGL(hymba_fwd<(1 << p)>, dim3(grid), dim3(NWAVES * 64), LDS_BYTES, stream, a); } while (0)
    LAUNCH_PH(0); LAUNCH_PH(1); LAUNCH_PH(2); LAUNCH_PH(3); LAUNCH_PH(4); LAUNCH_PH(5); LAUNCH_PH(6); LAUNCH_PH(7); LAUNCH_PH(8);
#endif
}
```

```cpp
#include <hip/hip_runtime.h>
#include <hip/hip_cooperative_groups.h>
#include <cstdio>
#include <cstdint>
namespace cg = cooperative_groups;

#ifndef MK_MASK
#define MK_MASK 511
#endif
#ifndef MK_ONE_LAUNCH
#define MK_ONE_LAUNCH 1
#endif

namespace pg8 {
#define PG8_LAS __attribute__((address_space(3)))
typedef unsigned short bf16_t;
typedef short bf16x8 __attribute__((ext_vector_type(8)));
typedef float f32x4 __attribute__((ext_vector_type(4)));
typedef unsigned u32x4 __attribute__((ext_vector_type(4)));
constexpr int BM = 256, BK = 64, HALF = 128, HTB = HALF * BK * 2  , STAGE_BYTES = 8 * HTB, NXCD = 8, WGM = 8;

__host__ __device__ __forceinline__ int lds_byte(int r, int c) { const int st = (r >> 4) * 2 + (c >> 5), rr = r & 15, cc = c & 31, ob = rr * 64 + cc * 2; return st * 1024 + (ob ^ (((ob >> 9) & 1) << 5)); }
__host__ __device__ __forceinline__ void stage_rc(int b, int& R, int& C) { const int st = b / 1024, sb = b % 1024, swz = sb ^ (((sb >> 9) & 1) << 5); R = (st >> 1) * 16 + swz / 64; C = (st & 1) * 32 + (swz % 64) / 2; }
__host__ __device__ __forceinline__ int perm32(int rho) { const int n = rho >> 4, i = rho & 15; return 8 * (i >> 2) + 4 * n + (i & 3); }

struct Unit { int pm, pn; };
struct Gemm { const bf16_t* A; const bf16_t* Bt; int M, N, K; };

struct StaticOrder {
    int nM, nN, nwg, G, c;
    __host__ __device__ void init(int M, int N, int G_, int c_) { nM = M / BM; nN = N / BM; nwg = nM * nN; G = G_; c = c_; }
    __host__ __device__ bool next(int i, Unit& u) const {
        const long L = (long)i * G + c; if (L >= nwg) return false;
        int wgid = (int)L; { const int q = nwg / NXCD, r = nwg % NXCD, xcd = wgid % NXCD, off = wgid / NXCD; wgid = (xcd < r ? xcd * (q + 1) : r * (q + 1) + (xcd - r) * q) + off; }
        const int nig = WGM * nN, gid = wgid / nig, fm = gid * WGM, gsz = (nM - fm) < WGM ? (nM - fm) : WGM;
        u.pm = fm + ((wgid % nig) % gsz); u.pn = (wgid % nig) / gsz; return true;
    }
    __device__ __forceinline__ void a_ready(const Unit&) const {}
    __device__ __forceinline__ void done(const Unit&) const {}
};

typedef unsigned u32x2 __attribute__((ext_vector_type(2)));
typedef float f32x2 __attribute__((ext_vector_type(2)));
typedef __bf16 bf16x2_cv __attribute__((ext_vector_type(2)));
__device__ __forceinline__ unsigned cvt_pk_bf16(float lo, float hi) { const f32x2 v = {lo, hi}; const bf16x2_cv b = __builtin_convertvector(v, bf16x2_cv); return __builtin_bit_cast(unsigned, b); }
__device__ __forceinline__ float gelu_tanh(float x) {
    const float z = x * (1.0f + 0.044715f * x * x);
    return x * __builtin_amdgcn_rcpf(1.0f + __builtin_amdgcn_exp2f(-2.302208198f * z));
}
__device__ __forceinline__ f32x4 gelu4(f32x4 v) { return (f32x4){gelu_tanh(v[0]), gelu_tanh(v[1]), gelu_tanh(v[2]), gelu_tanh(v[3])}; }
__device__ __forceinline__ f32x4 shfl4(f32x4 v, int m) { return (f32x4){__shfl_xor(v[0], m), __shfl_xor(v[1], m), __shfl_xor(v[2], m), __shfl_xor(v[3], m)}; }
__device__ __forceinline__ u32x4 pack8(f32x4 a, f32x4 b) { u32x4 w; w.x = cvt_pk_bf16(a[0], a[1]); w.y = cvt_pk_bf16(a[2], a[3]); w.z = cvt_pk_bf16(b[0], b[1]); w.w = cvt_pk_bf16(b[2], b[3]); return w; }
__device__ __forceinline__ u32x2 pack4(f32x4 a) { u32x2 w; w.x = cvt_pk_bf16(a[0], a[1]); w.y = cvt_pk_bf16(a[2], a[3]); return w; }
__device__ __forceinline__ float bf2f(unsigned short b) { return __uint_as_float((unsigned)b << 16); }
__device__ __forceinline__ f32x4 unpack4(u32x2 w) { return (f32x4){__uint_as_float(w.x << 16), __uint_as_float(w.x & 0xffff0000u), __uint_as_float(w.y << 16), __uint_as_float(w.y & 0xffff0000u)}; }
constexpr float QSCALE = 0.125f * 1.4426950408889634f;
constexpr float EPS = 1e-6f;


struct EpiIn {
    static constexpr bool PERM = true, AFTER_DRAIN = false;
    bf16_t *Q, *Kb, *Vb, *U, *VC; const float* rope; float* outk; float* outv;
    __device__ __forceinline__ void operator()(const f32x4 (&acc)[2][2][4][2], const Unit& u, int wr, int wc, int fr, int fq) const {
        const int seg = u.pn >> 1;
        const int row0 = u.pm * BM + wr * 64 + fr, lc0 = (u.pn & 1) * 256 + wc * 32 + 8 * fq;
        bf16_t* base = seg == 0 ? Q : seg == 1 ? Kb : seg == 2 ? Vb : seg == 3 ? U : VC;
        float* fout = seg == 1 ? outk : outv;
        const bool ropeseg = (seg < 2) && ((wc & 1) == 0);
#pragma unroll
        for (int ai = 0; ai < 2; ++ai)
#pragma unroll
            for (int m = 0; m < 4; ++m) {
                const int row = row0 + ai * HALF + m * 16;
                f32x4 c0 = {1.f, 1.f, 1.f, 1.f}, c1 = c0, s0 = {0.f, 0.f, 0.f, 0.f}, s1 = s0;
                if (ropeseg) { const f32x4* rp = (const f32x4*)(rope + (size_t)row * 16); c0 = rp[0]; c1 = rp[1]; s0 = rp[2]; s1 = rp[3]; if (fq == 0) { s0 = -s0; s1 = -s1; } if (fq >= 2) { c0 = (f32x4){1.f, 1.f, 1.f, 1.f}; c1 = c0; s0 = (f32x4){0.f, 0.f, 0.f, 0.f}; s1 = s0; } }
#pragma unroll
                for (int bj = 0; bj < 2; ++bj) {
                    f32x4 v0 = acc[ai][bj][m][0], v1 = acc[ai][bj][m][1];
                    if (ropeseg) { const f32x4 p0 = shfl4(v0, 16), p1 = shfl4(v1, 16); v0 = v0 * c0 + p0 * s0; v1 = v1 * c1 + p1 * s1; }
                    if (seg == 0) { v0 = v0 * QSCALE; v1 = v1 * QSCALE; }
                    if (seg >= 3) { v0 = gelu4(v0); v1 = gelu4(v1); }
                    const size_t off = (size_t)row * 512 + lc0 + bj * HALF;
                    *(u32x4*)(base + off) = pack8(v0, v1);
                    if ((seg == 1 || seg == 2) && row >= 16384 - 2048) { float* o = fout + (size_t)(row - (16384 - 2048)) * 512 + lc0 + bj * HALF; *(f32x4*)o = v0; *(f32x4*)(o + 4) = v1; }
                }
                asm volatile("" ::: "memory");
            }
    }
};
struct EpiBf {
    static constexpr bool PERM = true, AFTER_DRAIN = false;
    bf16_t* O; static constexpr int ldc = 1024;
    __device__ __forceinline__ void operator()(const f32x4 (&acc)[2][2][4][2], const Unit& u, int wr, int wc, int fr, int fq) const {
        const int row0 = u.pm * BM + wr * 64 + fr, col0 = u.pn * BM + wc * 32 + 8 * fq;
#pragma unroll
        for (int ai = 0; ai < 2; ++ai)
#pragma unroll
            for (int m = 0; m < 4; ++m)
#pragma unroll
                for (int bj = 0; bj < 2; ++bj) *(u32x4*)(O + (size_t)(row0 + ai * HALF + m * 16) * ldc + col0 + bj * HALF) = pack8(acc[ai][bj][m][0], acc[ai][bj][m][1]);
    }
};
__device__ __forceinline__ float rstd_from_slots16(const float* p) {
    const f32x4 a = ((const f32x4*)p)[0], b = ((const f32x4*)p)[1], c = ((const f32x4*)p)[2], d = ((const f32x4*)p)[3];
    const float s = ((a[0] + a[1]) + (a[2] + a[3])) + ((b[0] + b[1]) + (b[2] + b[3])) + ((c[0] + c[1]) + (c[2] + c[3])) + ((d[0] + d[1]) + (d[2] + d[3]));
    return 1.0f / sqrtf(s * (1.0f / 1024.0f) + EPS);
}
struct EpiUp {
    static constexpr bool PERM = true, AFTER_DRAIN = false;
    bf16_t* O; const float* ssq;
    __device__ __forceinline__ void operator()(const f32x4 (&acc)[2][2][4][2], const Unit& u, int wr, int wc, int fr, int fq) const {
        const int row0 = u.pm * BM + wr * 64 + fr, col0 = u.pn * BM + wc * 32 + 8 * fq;
#pragma unroll
        for (int ai = 0; ai < 2; ++ai)
#pragma unroll
            for (int m = 0; m < 4; ++m) { const int row = row0 + ai * HALF + m * 16; const float rs = rstd_from_slots16(ssq + (size_t)row * 16);
#pragma unroll
                for (int bj = 0; bj < 2; ++bj) { f32x4 v0 = acc[ai][bj][m][0] * rs, v1 = acc[ai][bj][m][1] * rs;
#pragma unroll
                    for (int e = 0; e < 4; ++e) { v0[e] = fmaxf(v0[e], 0.f); v0[e] *= v0[e]; v1[e] = fmaxf(v1[e], 0.f); v1[e] *= v1[e]; }
                    *(u32x4*)(O + (size_t)row * 4096 + col0 + bj * HALF) = pack8(v0, v1); } }
    }
};
template <bool BASE_F32> struct EpiRes {
    static constexpr bool PERM = false, AFTER_DRAIN = false;
    const void* base; bf16_t* outb; float* ssq;
    __device__ __forceinline__ void operator()(const f32x4 (&acc)[2][2][4][2], const Unit& u, int wr, int wc, int fr, int fq) const {
        const int row0 = u.pm * BM + wr * 64 + fr, col0 = u.pn * BM + wc * 32 + 4 * fq;
#pragma unroll
        for (int ai = 0; ai < 2; ++ai) {
            f32x4 pre[4][2][2];
#pragma unroll
            for (int m = 0; m < 4; ++m)
#pragma unroll
                for (int bj = 0; bj < 2; ++bj)
#pragma unroll
                    for (int n = 0; n < 2; ++n) { const size_t c = (size_t)(row0 + ai * HALF + m * 16) * 1024 + col0 + bj * HALF + n * 16;
                        pre[m][bj][n] = BASE_F32 ? __builtin_nontemporal_load((const f32x4*)((const float*)base + c)) : unpack4(*(const u32x2*)((const bf16_t*)base + c)); }
#pragma unroll
            for (int m = 0; m < 4; ++m) { const int row = row0 + ai * HALF + m * 16; const size_t off = (size_t)row * 1024 + col0; float s = 0.f;
#pragma unroll
                for (int bj = 0; bj < 2; ++bj)
#pragma unroll
                    for (int n = 0; n < 2; ++n) { const size_t c = off + bj * HALF + n * 16;
                        const u32x2 w = pack4(pre[m][bj][n] + acc[ai][bj][m][n]); const f32x4 o = unpack4(w);
                        s += (o[0] * o[0] + o[1] * o[1]) + (o[2] * o[2] + o[3] * o[3]); *(u32x2*)(outb + c) = w; }
                s += __shfl_xor(s, 16); s += __shfl_xor(s, 32);
                if (fq == 0) ssq[(size_t)row * 16 + u.pn * 4 + wc] = s; }
            asm volatile("" ::: "memory");
        }
    }
};
struct EpiGateFinal {
    static constexpr bool PERM = false, AFTER_DRAIN = true;
    const bf16_t* h2; const bf16_t* ple; const float* ssq_in; const float* fgain; float* out; float* slots; unsigned* cnt;
    __device__ __forceinline__ void fused(f32x4 (&acc)[2][2][4][2], const Unit& u, int wr, int wc, int fr, int fq, PG8_LAS unsigned char* lds, int wid, int lane) const {
        const int row0 = u.pm * BM + wr * 64 + fr, col0 = u.pn * BM + wc * 32 + 4 * fq;
        PG8_LAS float* RS = (PG8_LAS float*)lds;
#pragma unroll
        for (int ai = 0; ai < 2; ++ai)
#pragma unroll
            for (int m = 0; m < 4; ++m) { const int row = row0 + ai * HALF + m * 16; const size_t off = (size_t)row * 1024 + col0; float s = 0.f;
                const float rs = rstd_from_slots16(ssq_in + (size_t)row * 16);
#pragma unroll
                for (int bj = 0; bj < 2; ++bj)
#pragma unroll
                    for (int n = 0; n < 2; ++n) { const size_t c = off + bj * HALF + n * 16; const f32x4 z = acc[ai][bj][m][n] * rs; const f32x4 pl = unpack4(*(const u32x2*)(ple + c)); f32x4 o = unpack4(*(const u32x2*)(h2 + c));
#pragma unroll
                        for (int e = 0; e < 4; ++e) o[e] += pl[e] * __builtin_amdgcn_rcpf(1.0f + __builtin_amdgcn_exp2f(-1.4426950408889634f * z[e]));
                        s += (o[0] * o[0] + o[1] * o[1]) + (o[2] * o[2] + o[3] * o[3]); acc[ai][bj][m][n] = o; }
                s += __shfl_xor(s, 16); s += __shfl_xor(s, 32);
                if (fq == 0) __hip_atomic_store(slots + (size_t)row * 16 + u.pn * 4 + wc, s, __ATOMIC_RELAXED, __HIP_MEMORY_SCOPE_AGENT);
                asm volatile("" : "+v"(acc[ai][0][m][0]), "+v"(acc[ai][0][m][1]), "+v"(acc[ai][1][m][0]), "+v"(acc[ai][1][m][1]));
                if (m & 1) asm volatile("" ::: "memory"); }
        asm volatile("s_waitcnt vmcnt(0)" ::: "memory");
        if (lane == 0) __hip_atomic_fetch_add(cnt + 64 * u.pm, 1u, __ATOMIC_RELEASE, __HIP_MEMORY_SCOPE_AGENT);
        if (wid == 0) {
            unsigned spins = 0;
            while ((unsigned)__builtin_amdgcn_readfirstlane(__hip_atomic_load(cnt + 64 * u.pm, __ATOMIC_RELAXED, __HIP_MEMORY_SCOPE_AGENT)) < 32u && ++spins < (1u << 22)) __builtin_amdgcn_s_sleep(2);
            __builtin_amdgcn_fence(__ATOMIC_ACQUIRE, "agent");
        }
        asm volatile("s_waitcnt vmcnt(0) lgkmcnt(0)" ::: "memory"); __builtin_amdgcn_s_barrier(); asm volatile("" ::: "memory");
        { const int tid = wid * 64 + lane;
          const float* sp = slots + (size_t)(u.pm * BM + (tid >> 1)) * 16 + 8 * (tid & 1); float t = 0.f;
#pragma unroll
          for (int e = 0; e < 8; ++e) t += __hip_atomic_load(sp + e, __ATOMIC_RELAXED, __HIP_MEMORY_SCOPE_AGENT);
          t += __shfl_xor(t, 1);
          if ((tid & 1) == 0) RS[tid >> 1] = 1.0f / sqrtf(t * (1.0f / 1024.0f) + EPS); }
        asm volatile("s_waitcnt lgkmcnt(0)" ::: "memory"); __builtin_amdgcn_s_barrier(); asm volatile("" ::: "memory");
        f32x4 gg[2][2];
#pragma unroll
        for (int bj = 0; bj < 2; ++bj)
#pragma unroll
            for (int n = 0; n < 2; ++n) gg[bj][n] = *(const f32x4*)(fgain + col0 + bj * HALF + n * 16);
#pragma unroll
        for (int ai = 0; ai < 2; ++ai)
#pragma unroll
            for (int m = 0; m < 4; ++m) { const int r = ai * HALF + wr * 64 + m * 16 + fr; const float rs = RS[r]; const size_t off = (size_t)(u.pm * BM + r) * 1024 + col0;
#pragma unroll
                for (int bj = 0; bj < 2; ++bj)
#pragma unroll
                    for (int n = 0; n < 2; ++n) *(f32x4*)(out + off + bj * HALF + n * 16) = acc[ai][bj][m][n] * rs * gg[bj][n]; }
    }
};
template <class Epi, class Sched, bool ALIGN_EPI = false, bool SP2 = false>
__device__ __forceinline__ void gemm_phase(PG8_LAS unsigned char* lds, const Gemm g, const Sched& S, const Epi& E) {
    const int tid = threadIdx.x, wid = __builtin_amdgcn_readfirstlane(tid >> 6), lane = tid & 63, wr = wid >> 2, wc = wid & 3, fr = lane & 15, fq = lane >> 4;
    const int K = g.K, nt = K / BK;
    unsigned voffA[2], voffB[2];
#pragma unroll
    for (int i = 0; i < 2; ++i) { int R, C; stage_rc(tid * 16 + i * 8192, R, C); const int Rb = Epi::PERM ? ((R & ~31) + perm32(R & 31)) : R;
        voffA[i] = (unsigned)(R * K + C) * 2u; voffB[i] = (unsigned)(Rb * K + C) * 2u; }
    const size_t kstep = (size_t)(BK * 2);
    const size_t hstep = (size_t)HALF * K * 2;
    const size_t tstep = 2 * hstep;
    const unsigned ldsw = (unsigned)wid * 1024u;
    const int aoff = lds_byte(wr * 64 + fr, fq * 8), boff = lds_byte(wc * 32 + fr, fq * 8);
#define PG8_SA(b, h) (((b) * 2 + (h)) * HTB)
#define PG8_SB(b, h) ((4 + (b) * 2 + (h)) * HTB)
#define PG8_STAGE(bufoff, gbase, voff) do { _Pragma("unroll") for (int _i = 0; _i < 2; ++_i) \
        __builtin_amdgcn_global_load_lds((const unsigned*)((const char*)(gbase) + (voff)[_i]), (PG8_LAS unsigned*)(lds + (bufoff) + ldsw + _i * 8192), 16, 0, 0); } while (0)
#define PG8_LDA(dst, b, h) do { _Pragma("unroll") for (int m = 0; m < 4; ++m) _Pragma("unroll") for (int k = 0; k < 2; ++k) dst[m][k] = *(const PG8_LAS bf16x8*)(lds + PG8_SA(b, h) + aoff + m * 2048 + k * 1024); } while (0)
#define PG8_LDB(dst, b, h) do { _Pragma("unroll") for (int n = 0; n < 2; ++n) _Pragma("unroll") for (int k = 0; k < 2; ++k) dst[n][k] = *(const PG8_LAS bf16x8*)(lds + PG8_SB(b, h) + boff + n * 2048 + k * 1024); } while (0)
#define PG8_MMA(ai, bj, At, Bt) do { __builtin_amdgcn_s_setprio(1); _Pragma("unroll") for (int m = 0; m < 4; ++m) _Pragma("unroll") for (int n = 0; n < 2; ++n) _Pragma("unroll") for (int k = 0; k < 2; ++k) \
        acc[ai][bj][m][n] = __builtin_amdgcn_mfma_f32_16x16x32_bf16(Bt[n][k], At[m][k], acc[ai][bj][m][n], 0, 0, 0); __builtin_amdgcn_s_setprio(0); } while (0)
#define PG8_WAIT_V(n) asm volatile("s_waitcnt vmcnt(" #n ")" ::: "memory")
#define PG8_WAIT_L(n) asm volatile("s_waitcnt lgkmcnt(" #n ")" ::: "memory")
#define PG8_BAR __builtin_amdgcn_s_barrier()
#define PG8_SCHED __builtin_amdgcn_sched_barrier(0)
    Unit cur, nxt; int ui = 0;
    if (!S.next(0, cur)) return;
    f32x4 acc[2][2][4][2];
#pragma unroll
    for (int a = 0; a < 2; ++a)
#pragma unroll
        for (int b = 0; b < 2; ++b)
#pragma unroll
            for (int m = 0; m < 4; ++m)
#pragma unroll
                for (int n = 0; n < 2; ++n) acc[a][b][m][n] = (f32x4){0.f, 0.f, 0.f, 0.f};
    bf16x8 At[4][2], B0[2][2], B1[2][2];
    const char* cA = (const char*)g.A + (size_t)cur.pm * tstep; const char* cB = (const char*)g.Bt + (size_t)cur.pn * tstep;
    S.a_ready(cur);
    if constexpr (SP2) {
        PG8_STAGE(PG8_SB(0, 0), cB, voffB); PG8_STAGE(PG8_SB(0, 1), cB + hstep, voffB); PG8_STAGE(PG8_SA(0, 0), cA, voffA); PG8_STAGE(PG8_SA(0, 1), cA + hstep, voffA);
        if (wr == 1) PG8_BAR;
        PG8_WAIT_V(2); PG8_BAR;
        PG8_STAGE(PG8_SB(1, 0), cB + kstep, voffB); PG8_STAGE(PG8_SA(1, 0), cA + kstep, voffA); PG8_STAGE(PG8_SB(1, 1), cB + hstep + kstep, voffB);
        PG8_WAIT_V(6); PG8_BAR;
    } else {
        PG8_STAGE(PG8_SB(0, 0), cB, voffB); PG8_STAGE(PG8_SA(0, 0), cA, voffA); PG8_STAGE(PG8_SB(0, 1), cB + hstep, voffB); PG8_STAGE(PG8_SA(0, 1), cA + hstep, voffA);
        if (wr == 1) PG8_BAR;
        PG8_WAIT_V(4); PG8_BAR;
        PG8_STAGE(PG8_SB(1, 0), cB + kstep, voffB); PG8_STAGE(PG8_SA(1, 0), cA + kstep, voffA); PG8_STAGE(PG8_SB(1, 1), cB + hstep + kstep, voffB);
        PG8_WAIT_V(6); PG8_BAR;
    }
    for (;;) {
        const bool has_next = S.next(ui + 1, nxt);
        const char* nA = has_next ? (const char*)g.A + (size_t)nxt.pm * tstep : cA; const char* nB = has_next ? (const char*)g.Bt + (size_t)nxt.pn * tstep : cB;
        for (int t = 0; t < nt; t += 2) {
            const bool last = (t == nt - 2);
            const char* a1 = cA + (size_t)(t + 1) * kstep;
            const char* a2 = last ? nA : cA + (size_t)(t + 2) * kstep; const char* b2 = last ? nB : cB + (size_t)(t + 2) * kstep;
            const char* a3 = a2 + kstep; const char* b3 = b2 + kstep;
            if (last && has_next) S.a_ready(nxt);
            if constexpr (SP2) {
            PG8_LDB(B0, 0, 0); PG8_LDB(B1, 0, 1); PG8_SCHED; PG8_LDA(At, 0, 0); PG8_STAGE(PG8_SA(1, 1), a1 + hstep, voffA);
            PG8_WAIT_V(8); PG8_WAIT_L(0); PG8_BAR; PG8_MMA(0, 0, At, B0); PG8_MMA(0, 1, At, B1); PG8_BAR; PG8_SCHED;
            PG8_LDA(At, 0, 1); PG8_STAGE(PG8_SB(0, 0), b2, voffB); PG8_STAGE(PG8_SB(0, 1), b2 + hstep, voffB); PG8_STAGE(PG8_SA(0, 0), a2, voffA);
            PG8_WAIT_V(8); PG8_WAIT_L(0); PG8_BAR; PG8_MMA(1, 0, At, B0); PG8_MMA(1, 1, At, B1); PG8_BAR; PG8_SCHED;
            PG8_LDB(B0, 1, 0); PG8_LDB(B1, 1, 1); PG8_SCHED; PG8_LDA(At, 1, 0); PG8_STAGE(PG8_SA(0, 1), a2 + hstep, voffA);
            PG8_WAIT_V(8); PG8_WAIT_L(0); PG8_BAR; PG8_MMA(0, 0, At, B0); PG8_MMA(0, 1, At, B1); PG8_BAR; PG8_SCHED;
            PG8_LDA(At, 1, 1); PG8_STAGE(PG8_SB(1, 0), b3, voffB); PG8_STAGE(PG8_SB(1, 1), b3 + hstep, voffB); PG8_STAGE(PG8_SA(1, 0), a3, voffA);
            PG8_WAIT_V(8); PG8_WAIT_L(0); PG8_BAR; PG8_MMA(1, 0, At, B0); PG8_MMA(1, 1, At, B1); PG8_BAR; PG8_SCHED;
            } else {
            PG8_LDB(B0, 0, 0); PG8_SCHED; PG8_LDA(At, 0, 0); PG8_STAGE(PG8_SA(1, 1), a1 + hstep, voffA);
            PG8_WAIT_L(8); PG8_BAR; PG8_WAIT_L(0); PG8_MMA(0, 0, At, B0); PG8_BAR; PG8_SCHED;
            PG8_LDB(B1, 0, 1); PG8_STAGE(PG8_SB(0, 0), b2, voffB);
            PG8_BAR; PG8_WAIT_L(0); PG8_MMA(0, 1, At, B1); PG8_BAR;
            PG8_LDA(At, 0, 1); PG8_STAGE(PG8_SA(0, 0), a2, voffA);
            PG8_BAR; PG8_WAIT_L(0); PG8_MMA(1, 0, At, B0); PG8_BAR; PG8_SCHED;
            PG8_STAGE(PG8_SB(0, 1), b2 + hstep, voffB);
            PG8_WAIT_V(6); PG8_BAR; PG8_MMA(1, 1, At, B1); PG8_BAR;
            PG8_LDB(B0, 1, 0); PG8_SCHED; PG8_LDA(At, 1, 0); PG8_STAGE(PG8_SA(0, 1), a2 + hstep, voffA);
            PG8_WAIT_L(8); PG8_BAR; PG8_WAIT_L(0); PG8_MMA(0, 0, At, B0); PG8_BAR; PG8_SCHED;
            PG8_LDB(B1, 1, 1); PG8_STAGE(PG8_SB(1, 0), b3, voffB);
            PG8_BAR; PG8_WAIT_L(0); PG8_MMA(0, 1, At, B1); PG8_BAR;
            PG8_LDA(At, 1, 1); PG8_STAGE(PG8_SA(1, 0), a3, voffA);
            PG8_BAR; PG8_WAIT_L(0); PG8_MMA(1, 0, At, B0); PG8_BAR; PG8_SCHED;
            PG8_STAGE(PG8_SB(1, 1), b3 + hstep, voffB);
            PG8_WAIT_V(6); PG8_BAR; PG8_MMA(1, 1, At, B1); PG8_BAR;
            }
        }
        if constexpr (ALIGN_EPI) { if (wr == 0) PG8_BAR; }
        if constexpr (!Epi::AFTER_DRAIN) { E(acc, cur, wr, wc, fr, fq); S.done(cur); }
        if (!has_next) break;
#pragma unroll
        for (int a = 0; a < 2; ++a)
#pragma unroll
            for (int b = 0; b < 2; ++b)
#pragma unroll
                for (int m = 0; m < 4; ++m)
#pragma unroll
                    for (int n = 0; n < 2; ++n) acc[a][b][m][n] = (f32x4){0.f, 0.f, 0.f, 0.f};
        cur = nxt; cA = nA; cB = nB; ++ui;
        if constexpr (ALIGN_EPI) { if (wr == 1) PG8_BAR; }
    }
    PG8_WAIT_V(0);
    if constexpr (!ALIGN_EPI) { if (wr == 0) PG8_BAR; }
    PG8_BAR;
    if constexpr (Epi::AFTER_DRAIN) { E.fused(acc, cur, wr, wc, fr, fq, lds, wid, lane); S.done(cur); }
#undef PG8_SA
#undef PG8_SB
#undef PG8_STAGE
#undef PG8_LDA
#undef PG8_LDB
#undef PG8_MMA
#undef PG8_WAIT_V
#undef PG8_WAIT_L
#undef PG8_BAR
#undef PG8_SCHED
}
}
using pg8::bf16_t; using pg8::bf16x8; using pg8::f32x4; using pg8::u32x4; using pg8::u32x2; using pg8::cvt_pk_bf16; using pg8::pack4; using pg8::pack8; using pg8::unpack4; using pg8::QSCALE; using pg8::EPS;
#define LAS __attribute__((address_space(3)))
typedef float f32x16 __attribute__((ext_vector_type(16)));
typedef short s16x4 __attribute__((ext_vector_type(4)));

constexpr int SEQ = 16384, DM = 1024, NSAMP = 128, MTOT = SEQ + NSAMP, INW = 2560, DFF = 4096, PLE = 256, PAST = 16384, LBUF = 2048;
constexpr int NWAVES = 8;

__device__ __forceinline__ int crow(int r, int hi) { return (r & 3) + 8 * (r >> 2) + 4 * hi; }
__device__ __forceinline__ s16x4 tr_read(const LAS unsigned char* p) { return __builtin_bit_cast(s16x4, __builtin_amdgcn_ds_read_tr16_b64_v4i16((LAS s16x4*)p)); }

constexpr int AK_PITCH = 144, AV_OFF = 384 * AK_PITCH;
struct AttnPre { u32x4 kv[6], vv[6]; };
__device__ __forceinline__ void attn_decode(int a, int& head, int& di, int& dil, int& r, int& m0) {
    head = a & 7; const int t = a >> 3; di = t >> 6; const int rng = t & 63;
    dil = di == 0 ? 1 : di == 1 ? 4 : 16; const int sh = di == 0 ? 6 : di == 1 ? 4 : 2;
    r = rng >> sh; m0 = (rng & ((1 << sh) - 1)) * 256;
}
__device__ __forceinline__ void attn_prefetch(AttnPre& P, int a, const bf16_t* K, const bf16_t* V) {
    int head, di, dil, r, m0; attn_decode(a, head, di, dil, r, m0); const int tid = threadIdx.x;
#pragma unroll
    for (int i = 0; i < 6; ++i) {
        const int id = tid + 512 * i, row = id >> 3, ch = id & 7, m = m0 - 128 + row;
        P.kv[i] = (u32x4){0u, 0u, 0u, 0u}; P.vv[i] = P.kv[i];
        if (m >= 0) { const size_t g = (size_t)(m * dil + r) * 512 + head * 64 + ch * 8; P.kv[i] = *(const u32x4*)(K + g); P.vv[i] = *(const u32x4*)(V + g); }
    }
}
__device__ __forceinline__ void attn_unit(LAS unsigned char* lds, int a, int anext, bool has_next, AttnPre& P, const bf16_t* Q, const bf16_t* K, const bf16_t* V, bf16_t* OU, float* LSE) {
    const int tid = threadIdx.x, lane = tid & 63, r32 = lane & 31, hi = lane >> 5; const int w = __builtin_amdgcn_readfirstlane(tid >> 6);
    int head, di, dil, r, m0; attn_decode(a, head, di, dil, r, m0);
    __syncthreads();
#pragma unroll
    for (int i = 0; i < 6; ++i) {
        const int id = tid + 512 * i, row = id >> 3, ch = id & 7;
        *(LAS u32x4*)(lds + row * AK_PITCH + ch * 16) = P.kv[i];
        *(LAS u32x4*)(lds + AV_OFF + (row >> 3) * 1024 + (ch >> 2) * 512 + (row & 7) * 64 + (ch & 3) * 16) = P.vv[i];
    }
    const int posq = (m0 + 32 * w + r32) * dil + r;
    bf16x8 qf[4];
#pragma unroll
    for (int ds = 0; ds < 4; ++ds) qf[ds] = *(const bf16x8*)(Q + (size_t)posq * 512 + head * 64 + ds * 16 + hi * 8);
    __syncthreads();
    if (has_next) attn_prefetch(P, anext, K, V);
    f32x16 s[5];
    const LAS unsigned char* kb = lds + (32 * w + r32) * AK_PITCH + hi * 16;
#pragma unroll
    for (int kt = 0; kt < 5; ++kt) {
        f32x16 c = {};
#pragma unroll
        for (int ds = 0; ds < 4; ++ds) { const bf16x8 kf = *(const LAS bf16x8*)(kb + kt * 32 * AK_PITCH + ds * 32); c = __builtin_amdgcn_mfma_f32_32x32x16_bf16(kf, qf[ds], c, 0, 0, 0); }
        s[kt] = c; __builtin_amdgcn_sched_barrier(0);
    }
#pragma unroll
    for (int i = 0; i < 16; ++i) { if (crow(i, hi) < r32) s[0][i] = -1e30f; if (crow(i, hi) > r32) s[4][i] = -1e30f; }
    const int kmin = 128 - m0 - 32 * w;
    if (kmin > 0) {
#pragma unroll
        for (int kt = 0; kt < 5; ++kt)
#pragma unroll
            for (int i = 0; i < 16; ++i) if (32 * kt + crow(i, hi) < kmin) s[kt][i] = -1e30f;
    }
    float mx = -1e30f;
#pragma unroll
    for (int kt = 0; kt < 5; ++kt)
#pragma unroll
        for (int i = 0; i < 16; ++i) mx = fmaxf(mx, s[kt][i]);
    mx = fmaxf(mx, __shfl_xor(mx, 32));
    float den = 0.f;
#pragma unroll
    for (int kt = 0; kt < 5; ++kt)
#pragma unroll
        for (int i = 0; i < 16; ++i) { const float p = __builtin_amdgcn_exp2f(s[kt][i] - mx); s[kt][i] = p; den += p; }
    den += __shfl_xor(den, 32);
    f32x16 o[2]; o[0] = f32x16{}; o[1] = f32x16{};
    const LAS unsigned char* vb = lds + AV_OFF + (4 * w) * 1024 + (4 * hi + ((lane & 15) >> 2)) * 64 + ((lane >> 4) & 1) * 32 + (lane & 3) * 8;
#pragma unroll
    for (int kt = 0; kt < 5; ++kt)
#pragma unroll
        for (int s2 = 0; s2 < 2; ++s2) {
            u32x4 pw; pw.x = cvt_pk_bf16(s[kt][8 * s2 + 0], s[kt][8 * s2 + 1]); pw.y = cvt_pk_bf16(s[kt][8 * s2 + 2], s[kt][8 * s2 + 3]); pw.z = cvt_pk_bf16(s[kt][8 * s2 + 4], s[kt][8 * s2 + 5]); pw.w = cvt_pk_bf16(s[kt][8 * s2 + 6], s[kt][8 * s2 + 7]);
            const bf16x8 pa = __builtin_bit_cast(bf16x8, pw);
#pragma unroll
            for (int d0 = 0; d0 < 2; ++d0) {
                const s16x4 lo = tr_read(vb + (4 * kt + 2 * s2) * 1024 + d0 * 512), hh = tr_read(vb + (4 * kt + 2 * s2 + 1) * 1024 + d0 * 512);
                const bf16x8 vf = (bf16x8){lo[0], lo[1], lo[2], lo[3], hh[0], hh[1], hh[2], hh[3]};
                o[d0] = __builtin_amdgcn_mfma_f32_32x32x16_bf16(vf, pa, o[d0], 0, 0, 0);
            }
            __builtin_amdgcn_sched_barrier(0);
        }
    const float rden = 1.0f / den;
    bf16_t* op = OU + ((size_t)di * SEQ + posq) * 512 + head * 64 + 4 * hi;
#pragma unroll
    for (int d0 = 0; d0 < 2; ++d0)
#pragma unroll
        for (int i4 = 0; i4 < 4; ++i4) { u32x2 wv; wv.x = cvt_pk_bf16(o[d0][4 * i4] * rden, o[d0][4 * i4 + 1] * rden); wv.y = cvt_pk_bf16(o[d0][4 * i4 + 2] * rden, o[d0][4 * i4 + 3] * rden); *(u32x2*)(op + 32 * d0 + 8 * i4) = wv; }
    if (hi == 0) LSE[((size_t)di * SEQ + posq) * 8 + head] = mx + __builtin_amdgcn_logf(den);
}

__device__ __forceinline__ void gmlp_unit(LAS unsigned char* lds, int unit, const bf16_t* VC, const bf16_t* U, const float* lng, const float* lnb, const bf16_t* Wsb, const float* bsp, bf16_t* MIX) {
    const int tid = threadIdx.x, lane = tid & 63, r32 = lane & 31, hi = lane >> 5; const int w = __builtin_amdgcn_readfirstlane(tid >> 6);
    const int c = unit >> 1, hf = unit & 1;
    __syncthreads();
    {
        const int tk = tid >> 2, qd = tid & 3; const bf16_t* src = VC + (size_t)(c * 128 + tk) * 512 + qd * 128;
        u32x4 raw[16]; float sum = 0.f;
#pragma unroll
        for (int i = 0; i < 16; ++i) { raw[i] = *(const u32x4*)(src + 8 * i);
#pragma unroll
            for (int e = 0; e < 4; ++e) sum += __uint_as_float(raw[i][e] << 16) + __uint_as_float(raw[i][e] & 0xffff0000u); }
        sum += __shfl_xor(sum, 1); sum += __shfl_xor(sum, 2);
        const float mean = sum * (1.0f / 512.0f); float sq = 0.f;
#pragma unroll
        for (int i = 0; i < 16; ++i)
#pragma unroll
            for (int e = 0; e < 4; ++e) { const float a = __uint_as_float(raw[i][e] << 16) - mean, b = __uint_as_float(raw[i][e] & 0xffff0000u) - mean; sq += a * a + b * b; }
        sq += __shfl_xor(sq, 1); sq += __shfl_xor(sq, 2);
        const float rstd = 1.0f / sqrtf(sq * (1.0f / 512.0f) + EPS);
        if ((qd >> 1) == hf) {
#pragma unroll
            for (int i = 0; i < 16; ++i) { const int ch = qd * 128 + 8 * i, gl = (ch >> 6) & 3, cl = ch & 63;
                const f32x4 g0 = *(const f32x4*)(lng + ch), g1 = *(const f32x4*)(lng + ch + 4), b0 = *(const f32x4*)(lnb + ch), b1 = *(const f32x4*)(lnb + ch + 4);
                f32x4 x0, x1;
                x0[0] = __uint_as_float(raw[i][0] << 16); x0[1] = __uint_as_float(raw[i][0] & 0xffff0000u); x0[2] = __uint_as_float(raw[i][1] << 16); x0[3] = __uint_as_float(raw[i][1] & 0xffff0000u);
                x1[0] = __uint_as_float(raw[i][2] << 16); x1[1] = __uint_as_float(raw[i][2] & 0xffff0000u); x1[2] = __uint_as_float(raw[i][3] << 16); x1[3] = __uint_as_float(raw[i][3] & 0xffff0000u);
                x0 = (x0 - mean) * rstd * g0 + b0; x1 = (x1 - mean) * rstd * g1 + b1;
                *(LAS u32x4*)(lds + gl * 16384 + (tk >> 3) * 1024 + (cl >> 5) * 512 + (tk & 7) * 64 + (cl & 31) * 2) = pack8(x0, x1); }
        }
    }
    __syncthreads();
    const int gl = w & 3, g = 4 * hf + gl;
    const LAS unsigned char* vb = lds + gl * 16384 + (lane & 12) * 16 + ((lane >> 4) & 1) * 32 + (lane & 3) * 8;
    const bf16_t* wg = Wsb + (size_t)g * 128 * 128;
#pragma unroll 1
    for (int q = 0; q < 2; ++q) {
        const int mt = (w < 4) ? (q ? 3 : 0) : (q ? 2 : 1), nks = 2 * mt + 2;
        f32x16 acc[2]; acc[0] = f32x16{}; acc[1] = f32x16{};
        const bf16_t* wrow = wg + (size_t)(32 * mt + r32) * 128 + 8 * hi;
        bf16x8 wf[8];
#pragma unroll
        for (int ks = 0; ks < 8; ++ks) wf[ks] = *(const bf16x8*)(wrow + 16 * (ks < nks ? ks : 0));
        const int tok = c * 128 + 32 * mt + r32; const float bias = bsp[g * 128 + 32 * mt + r32];
        u32x2 uu[2][4];
#pragma unroll
        for (int nt = 0; nt < 2; ++nt)
#pragma unroll
            for (int i4 = 0; i4 < 4; ++i4) uu[nt][i4] = *(const u32x2*)(U + (size_t)tok * 512 + 64 * g + 32 * nt + 8 * i4 + 4 * hi);
#pragma unroll
        for (int ks = 0; ks < 8; ++ks) {
            if (ks < nks) {
#pragma unroll
                for (int nt = 0; nt < 2; ++nt) {
                    const s16x4 lo = tr_read(vb + (2 * ks + hi) * 1024 + nt * 512), hh = tr_read(vb + (2 * ks + hi) * 1024 + nt * 512 + 256);
                    const bf16x8 vf = (bf16x8){lo[0], lo[1], lo[2], lo[3], hh[0], hh[1], hh[2], hh[3]};
                    acc[nt] = __builtin_amdgcn_mfma_f32_32x32x16_bf16(vf, wf[ks], acc[nt], 0, 0, 0);
                }
            }
        }
#pragma unroll
        for (int nt = 0; nt < 2; ++nt)
#pragma unroll
            for (int i4 = 0; i4 < 4; ++i4) { const int ch = 64 * g + 32 * nt + 8 * i4 + 4 * hi;
                f32x4 mv = {acc[nt][4 * i4], acc[nt][4 * i4 + 1], acc[nt][4 * i4 + 2], acc[nt][4 * i4 + 3]};
                mv = (mv + bias) * unpack4(uu[nt][i4]); *(u32x2*)(MIX + (size_t)tok * 1024 + 512 + ch) = pack4(mv); }
    }
}
__device__ __forceinline__ float wave_sum(float v) {
#pragma unroll
    for (int o = 1; o < 64; o <<= 1) v += __shfl_xor(v, o);
    return v;
}
__device__ __forceinline__ float red16(float v) { v += __shfl_xor(v, 1); v += __shfl_xor(v, 2); v += __shfl_xor(v, 4); v += __shfl_xor(v, 8); return v; }

__device__ __forceinline__ void samp_attn_task(int t, int lane, const float* QS, const float* KS, const float* VS, const float* ck, const float* cv, float* OUS, float* LSES) {
    const int half = t & 1, t2 = t >> 1, di = t2 % 3, tq = t2 / 3, j = tq & 3, h = (tq >> 2) & 7, b = tq >> 5, kg = lane >> 4, d4 = lane & 15;
    const int dl = di == 0 ? 1 : di == 1 ? 4 : 16, i0 = 68 * half;
    const f32x4 q = *(const f32x4*)(QS + (size_t)(b * 4 + j) * 512 + h * 64 + 4 * d4);
    float s[17]; float m = -1e30f;
#pragma unroll
    for (int it = 0; it < 17; ++it) {
        const int i = i0 + 4 * it + kg; const bool ok = i <= 128; const int idx = LBUF + j - dl * (ok ? i : 128);
        const float* kp = idx >= LBUF ? KS + (size_t)(b * 4 + idx - LBUF) * 512 + h * 64 : ck + (((size_t)b * LBUF + idx) * 8 + h) * 64;
        const f32x4 kv = *(const f32x4*)(kp + 4 * d4);
        float p = (q[0] * kv[0] + q[1] * kv[1]) + (q[2] * kv[2] + q[3] * kv[3]);
        p = red16(p); p = ok ? p : -1e30f; s[it] = p; m = fmaxf(m, p);
    }
    m = fmaxf(m, __shfl_xor(m, 16)); m = fmaxf(m, __shfl_xor(m, 32));
    float den = 0.f; f32x4 acc = {0.f, 0.f, 0.f, 0.f};
#pragma unroll
    for (int it = 0; it < 17; ++it) {
        const int i = i0 + 4 * it + kg; const bool ok = i <= 128; const int idx = LBUF + j - dl * (ok ? i : 128);
        const float* vp = idx >= LBUF ? VS + (size_t)(b * 4 + idx - LBUF) * 512 + h * 64 : cv + (((size_t)b * LBUF + idx) * 8 + h) * 64;
        const f32x4 vv = *(const f32x4*)(vp + 4 * d4);
        const float p = __builtin_amdgcn_exp2f(s[it] - m); den += p; acc = acc + vv * p;
    }
    den += __shfl_xor(den, 16); den += __shfl_xor(den, 32);
#pragma unroll
    for (int e = 0; e < 4; ++e) { acc[e] += __shfl_xor(acc[e], 16); acc[e] += __shfl_xor(acc[e], 32); }
    const float rd = 1.0f / den; const int part = di * 2 + half;
    if (kg == 0) *(f32x4*)(OUS + ((size_t)part * NSAMP + b * 4 + j) * 512 + h * 64 + 4 * d4) = acc * rd;
    if (lane == 0) LSES[((size_t)part * NSAMP + b * 4 + j) * 8 + h] = m + __builtin_amdgcn_logf(den);
}
__device__ __forceinline__ void samp_gmlp_task(int b, int lane, const float* VCS, const float* US, const float* lng, const float* lnb, const float* ws, const float* bs, float* outvc, bf16_t* MIX) {
    const int ch = 8 * lane, g = lane >> 3;
    const f32x4 g0 = *(const f32x4*)(lng + ch), g1 = *(const f32x4*)(lng + ch + 4), b0 = *(const f32x4*)(lnb + ch), b1 = *(const f32x4*)(lnb + ch + 4);
    f32x4 vn[4][2];
#pragma unroll
    for (int j = 0; j < 4; ++j) {
        f32x4 x0 = *(const f32x4*)(VCS + (size_t)(b * 4 + j) * 512 + ch), x1 = *(const f32x4*)(VCS + (size_t)(b * 4 + j) * 512 + ch + 4);
        const float mean = wave_sum(((x0[0] + x0[1]) + (x0[2] + x0[3])) + ((x1[0] + x1[1]) + (x1[2] + x1[3]))) * (1.0f / 512.0f);
        x0 = x0 - mean; x1 = x1 - mean;
        const float var = wave_sum(((x0[0] * x0[0] + x0[1] * x0[1]) + (x0[2] * x0[2] + x0[3] * x0[3])) + ((x1[0] * x1[0] + x1[1] * x1[1]) + (x1[2] * x1[2] + x1[3] * x1[3]))) * (1.0f / 512.0f);
        const float rstd = 1.0f / sqrtf(var + EPS);
        x0 = x0 * rstd * g0 + b0; x1 = x1 * rstd * g1 + b1; vn[j][0] = x0; vn[j][1] = x1;
        *(f32x4*)(outvc + (size_t)(b * 4 + j) * 512 + ch) = x0; *(f32x4*)(outvc + (size_t)(b * 4 + j) * 512 + ch + 4) = x1;
    }
#pragma unroll
    for (int i = 0; i < 4; ++i) {
        const float bias = bs[g * 128 + i]; f32x4 m0 = {bias, bias, bias, bias}, m1 = m0;
#pragma unroll
        for (int j = 0; j <= i; ++j) { const float wv = ws[((size_t)g * 128 + i) * 128 + j]; m0 = m0 + vn[j][0] * wv; m1 = m1 + vn[j][1] * wv; }
        const f32x4 u0 = *(const f32x4*)(US + (size_t)(b * 4 + i) * 512 + ch), u1 = *(const f32x4*)(US + (size_t)(b * 4 + i) * 512 + ch + 4);
        *(u32x4*)(MIX + (size_t)(SEQ + b * 4 + i) * 1024 + 512 + ch) = pack8(u0 * m0, u1 * m1);
    }
}
template <int SPLIT, class F>
__device__ __forceinline__ void small_gemm(LAS unsigned char* lds, const bf16_t* A, const bf16_t* Bt, int K, int N, int bx, int G, int wave, int lane, const F& f) {
    constexpr int TPB = NWAVES / SPLIT;
    const int fr = lane & 15, fq = lane >> 4, ntiles = 8 * (N >> 4), ks = wave & (SPLIT - 1), tl = wave / SPLIT, kchunk = K / SPLIT;
    LAS f32x4* red = (LAS f32x4*)lds;
    for (int t0 = bx * TPB; t0 < ntiles; t0 += G * TPB) {
        const int t = t0 + tl, mt = t & 7, nt = t >> 3;
        const bf16_t* ap = A + (size_t)(mt * 16 + fr) * K + fq * 8 + ks * kchunk; const bf16_t* bp = Bt + (size_t)(nt * 16 + fr) * K + fq * 8 + ks * kchunk;
        f32x4 acc = {0.f, 0.f, 0.f, 0.f};
        bf16x8 a0[8], b0[8], a1[8], b1[8];
#define SG_LOAD(a, b, k) do { _Pragma("unroll") for (int i_ = 0; i_ < 8; ++i_) { a[i_] = *(const bf16x8*)(ap + (k) + 32 * i_); b[i_] = *(const bf16x8*)(bp + (k) + 32 * i_); } } while (0)
#define SG_MMA(a, b) do { _Pragma("unroll") for (int i_ = 0; i_ < 8; ++i_) acc = __builtin_amdgcn_mfma_f32_16x16x32_bf16(a[i_], b[i_], acc, 0, 0, 0); } while (0)
        SG_LOAD(a0, b0, 0);
#pragma unroll 1
        for (int k = 0; k < kchunk; k += 512) {
            const bool m1 = k + 256 < kchunk, m2 = k + 512 < kchunk;
            if (m1) SG_LOAD(a1, b1, k + 256);
            SG_MMA(a0, b0);
            if (m1) { if (m2) SG_LOAD(a0, b0, k + 512); SG_MMA(a1, b1); }
        }
#undef SG_LOAD
#undef SG_MMA
        if (SPLIT > 1) {
            __syncthreads();
            if (ks) red[wave * 64 + lane] = acc;
            __syncthreads();
            if (ks == 0) {
#pragma unroll
                for (int s_ = 1; s_ < SPLIT; ++s_) acc = acc + red[(wave + s_) * 64 + lane];
                f(mt * 16 + 4 * fq, nt * 16 + fr, nt, acc);
            }
        } else f(mt * 16 + 4 * fq, nt * 16 + fr, nt, acc);
    }
}
template <int SPLIT, class F>
__device__ __forceinline__ void small_gemm_w64(LAS unsigned char* lds, const bf16_t* A, const bf16_t* Bt, int K, int N, int bx, int G, int wave, int lane, const F& f) {
    constexpr int TPB = NWAVES / SPLIT;
    const int fr = lane & 15, fq = lane >> 4, ngroups = 8 * (N >> 6), ks = wave & (SPLIT - 1), tl = wave / SPLIT, kchunk = K / SPLIT;
    LAS f32x4* red = (LAS f32x4*)lds;
    for (int t0 = bx * TPB; t0 < ngroups; t0 += G * TPB) {
        const int t = t0 + tl, mt = t & 7, ng = t >> 3;
        const bf16_t* ap = A + (size_t)(mt * 16 + fr) * K + fq * 8 + ks * kchunk; const bf16_t* bp = Bt + (size_t)(ng * 64 + fr) * K + fq * 8 + ks * kchunk;
        f32x4 acc[4]; acc[0] = (f32x4){0.f, 0.f, 0.f, 0.f}; acc[1] = acc[0]; acc[2] = acc[0]; acc[3] = acc[0];
        bf16x8 a0[4], b0[4][4], a1[4], b1[4][4];
#define SGW_LOAD(a, b, k) do { _Pragma("unroll") for (int i_ = 0; i_ < 4; ++i_) { a[i_] = *(const bf16x8*)(ap + (k) + 32 * i_); _Pragma("unroll") for (int j_ = 0; j_ < 4; ++j_) b[i_][j_] = *(const bf16x8*)(bp + (size_t)(16 * j_) * K + (k) + 32 * i_); } } while (0)
#define SGW_MMA(a, b) do { _Pragma("unroll") for (int i_ = 0; i_ < 4; ++i_) _Pragma("unroll") for (int j_ = 0; j_ < 4; ++j_) acc[j_] = __builtin_amdgcn_mfma_f32_16x16x32_bf16(a[i_], b[i_][j_], acc[j_], 0, 0, 0); } while (0)
        SGW_LOAD(a0, b0, 0);
#pragma unroll 1
        for (int k = 0; k < kchunk; k += 256) {
            const bool m1 = k + 128 < kchunk, m2 = k + 256 < kchunk;
            if (m1) SGW_LOAD(a1, b1, k + 128);
            SGW_MMA(a0, b0);
            if (m1) { if (m2) SGW_LOAD(a0, b0, k + 256); SGW_MMA(a1, b1); }
        }
#undef SGW_LOAD
#undef SGW_MMA
        if (SPLIT > 1) {
            __syncthreads();
            if (ks) {
#pragma unroll
                for (int j = 0; j < 4; ++j) red[(wave * 4 + j) * 64 + lane] = acc[j]; }
            __syncthreads();
            if (ks == 0) {
#pragma unroll
                for (int s_ = 1; s_ < SPLIT; ++s_)
#pragma unroll
                    for (int j = 0; j < 4; ++j) acc[j] = acc[j] + red[((wave + s_) * 4 + j) * 64 + lane];
            }
        }
        if (ks == 0) {
#pragma unroll
            for (int j = 0; j < 4; ++j) f(mt * 16 + 4 * fq, ng * 64 + j * 16 + fr, ng * 4 + j, acc[j]);
        }
    }
}
__device__ __forceinline__ float rstd_from_slots64(const float* p, int fr) {
    const f32x4 a = *(const f32x4*)(p + 4 * fr); return 1.0f / sqrtf(red16((a[0] + a[1]) + (a[2] + a[3])) * (1.0f / 1024.0f) + EPS);
}

__device__ __forceinline__ unsigned f2bf(float f) { unsigned u = __builtin_bit_cast(unsigned, f); return (u + 0x7fffu + ((u >> 16) & 1u)) >> 16; }
__device__ __forceinline__ unsigned pk2(float lo, float hi) { return f2bf(lo) | (f2bf(hi) << 16); }
struct TrItem { const float* W; bf16_t* WT; const float* gain; int K, N, k0, n0; };
__device__ __forceinline__ void p0_tr_load(const TrItem& it, float (&tv)[32], int lane) {
#pragma unroll
    for (int i = 0; i < 32; ++i) { const int kk = 2 * i + (lane >> 5); tv[i] = __builtin_nontemporal_load(it.W + (size_t)(it.k0 + kk) * it.N + it.n0 + (lane & 31)); }
}
__device__ __forceinline__ void p0_tr_store(const TrItem& it, float (&tv)[32], LAS float* scr, int lane) {
    if (it.gain) {
#pragma unroll
        for (int i = 0; i < 32; ++i) tv[i] *= it.gain[it.k0 + 2 * i + (lane >> 5)]; }
#pragma unroll
    for (int i = 0; i < 32; ++i) scr[(2 * i + (lane >> 5)) * 33 + (lane & 31)] = tv[i];
    asm volatile("s_waitcnt lgkmcnt(0)" ::: "memory");
    const int c = lane & 7;
#pragma unroll
    for (int j = 0; j < 4; ++j) { const int n = (lane >> 3) + 8 * j; const LAS float* sp = scr + (8 * c) * 33 + n;
        u32x4 o; o.x = pk2(sp[0 * 33], sp[1 * 33]); o.y = pk2(sp[2 * 33], sp[3 * 33]); o.z = pk2(sp[4 * 33], sp[5 * 33]); o.w = pk2(sp[6 * 33], sp[7 * 33]);
        *(u32x4*)(it.WT + (size_t)(it.n0 + n) * it.K + it.k0 + 8 * c) = o; }
    asm volatile("s_waitcnt lgkmcnt(0)" ::: "memory");
}
__device__ __forceinline__ void sincos_d(double a, float& s, float& c) {
    const double k = rint(a * 0.6366197723675814);
    const double r = fma(-k, 6.123233995736766e-17, fma(-k, 1.5707963267948966, a)), r2 = r * r;
    const double sp = r * (1.0 + r2 * (-1.0 / 6 + r2 * (1.0 / 120 + r2 * (-1.0 / 5040 + r2 * (1.0 / 362880 + r2 * (-1.0 / 39916800 + r2 * (1.0 / 6227020800.0)))))));
    const double cp = 1.0 + r2 * (-0.5 + r2 * (1.0 / 24 + r2 * (-1.0 / 720 + r2 * (1.0 / 40320 + r2 * (-1.0 / 3628800 + r2 * (1.0 / 479001600 + r2 * (-1.0 / 87178291200.0)))))));
    const int qd = (int)k & 3;
    const double sv = qd == 0 ? sp : qd == 1 ? cp : qd == 2 ? -sp : -cp, cv = qd == 0 ? cp : qd == 1 ? -sp : qd == 2 ? -cp : sp;
    s = (float)sv; c = (float)cv;
}
#define XB_TMO      128
#define XB_XCNT(j)  (256  + 64 * (j))
#define XB_XSUB(j)  (1280 + 64 * (j))
#define XB_XGEN(j)  (2304 + 64 * (j))
#define XB_TOP      3328
#define XB_TOPGEN   3392
#define XCD_BAR_WORDS 3456
#define XB_SPIN_CAP (1u << 18)

__device__ __forceinline__ unsigned xb_ld(unsigned* p)              { return __hip_atomic_load(p, __ATOMIC_RELAXED, __HIP_MEMORY_SCOPE_AGENT); }
__device__ __forceinline__ unsigned xb_add(unsigned* p, unsigned v) { return __hip_atomic_fetch_add(p, v, __ATOMIC_RELAXED, __HIP_MEMORY_SCOPE_AGENT); }
__device__ __forceinline__ unsigned xb_xcc_id() { return (unsigned)__builtin_amdgcn_s_getreg((3 << 11) | 20) & 0xFu; }
#define XB_SPIN(cond, bar) do { unsigned _sp = 0; while (cond) { __builtin_amdgcn_s_sleep(1); \
    if ((++_sp & 255u) == 0u) { if (xb_ld(&(bar)[XB_TMO])) break; if (_sp > XB_SPIN_CAP) { atomicAdd(&(bar)[XB_TMO], 1u); break; } } } } while (0)

struct XcdBarrier {
    unsigned* bar; unsigned x;
    volatile LAS unsigned* st;
};

__device__ __forceinline__ XcdBarrier xcd_barrier_post(unsigned* bar, volatile LAS unsigned* st) {
    XcdBarrier b; b.bar = bar; b.x = xb_xcc_id(); b.st = st;
    if (threadIdx.x == 0) (void)xb_add(&bar[XB_XCNT(b.x)], 1u);
    return b;
}
__device__ __forceinline__ void xcd_barrier_complete(unsigned* bar, unsigned x, unsigned& nloc, unsigned& nx) {
    const unsigned G = gridDim.x * gridDim.y * gridDim.z;
    unsigned sum, cnt, mine, sp = 0u;
    for (;;) {
        sum = 0u; cnt = 0u; mine = 0u;
#pragma unroll
        for (unsigned j = 0; j < 16; ++j) { const unsigned c = xb_ld(&bar[XB_XCNT(j)]); sum += c; cnt += (c > 0u) ? 1u : 0u; mine = (j == x) ? c : mine; }
        if (sum == G) break;
        __builtin_amdgcn_s_sleep(1);
        if ((++sp & 255u) == 0u) { if (xb_ld(&bar[XB_TMO])) break; if (sp > XB_SPIN_CAP) { atomicAdd(&bar[XB_TMO], 1u); break; } }
    }
    nloc = mine > 0u ? mine : 1u; nx = cnt > 0u ? cnt : 1u;
}

__device__ __forceinline__ void xcd_barrier(const XcdBarrier& b) {
    asm volatile("s_waitcnt vmcnt(0)" ::: "memory");
    __syncthreads();
    if (threadIdx.x == 0) {
        unsigned* bar = b.bar;
        __builtin_amdgcn_s_waitcnt(0);
        unsigned nloc = b.st[0], nx = b.st[1];
        if (nloc == 0u) { xcd_barrier_complete(bar, b.x, nloc, nx); b.st[0] = nloc; b.st[1] = nx; }
        const unsigned old = xb_add(&bar[XB_XSUB(b.x)], 1u);
        const unsigned gen = old / nloc;
        if (old + 1u == (gen + 1u) * nloc) {
            __builtin_amdgcn_fence(__ATOMIC_RELEASE, "agent");
            asm volatile("s_waitcnt vmcnt(0)" ::: "memory");
            const unsigned og = xb_add(&bar[XB_TOP], 1u);
            const unsigned tg = og / nx;
            if (og + 1u == (tg + 1u) * nx) xb_add(&bar[XB_TOPGEN], 1u);
            else XB_SPIN(xb_ld(&bar[XB_TOPGEN]) == tg, bar);
            __builtin_amdgcn_fence(__ATOMIC_ACQUIRE, "agent");
            xb_add(&bar[XB_XGEN(b.x)], 1u);
            asm volatile("s_waitcnt vmcnt(0)" ::: "memory");
        } else {
            XB_SPIN(xb_ld(&bar[XB_XGEN(b.x)]) == gen, bar);
            __builtin_amdgcn_fence(__ATOMIC_ACQUIRE, "agent");
            asm volatile("s_waitcnt vmcnt(0)" ::: "memory");
        }
    }
    __syncthreads();
}

constexpr size_t MiB = 1u << 20;
constexpr size_t WS_WIN = 1 * MiB, WS_WOUT = 6 * MiB, WS_WUP = 8 * MiB, WS_WDOWN = 16 * MiB, WS_WGATE = 24 * MiB, WS_WPLE = 26 * MiB, WS_WSB = 27 * MiB, WS_ROPE = 28 * MiB;
constexpr size_t WS_SMALL = 30 * MiB, WS_SSQ = 32 * MiB, WS_LSE = 35 * MiB, WS_PB = 38 * MiB, WS_ACT = 48 * MiB, WS_H1 = 82 * MiB, WS_PLEB = 148 * MiB, WS_MIX = 182 * MiB, WS_BIG = 216 * MiB, WS_END = 346 * MiB;
constexpr size_t OUT_KP = (size_t)MTOT * DM, OUT_VP = OUT_KP + 2048 * 512, OUT_KS = OUT_VP + 2048 * 512, OUT_VS = OUT_KS + NSAMP * 512, OUT_VC = OUT_VS + NSAMP * 512, OUT_END = OUT_VC + NSAMP * 512;
constexpr int LDS_BYTES = 147456;
constexpr int NPH = 9;

struct PleOrder {
    int c, G;
    __device__ bool next(int i, pg8::Unit& u) const {
        const int half = G >> 1, L = (G == 256) ? i * half + (c - half) : i * G + c;
        if (L >= 256 || (G == 256 && c < half)) return false;
        u.pm = L >> 2; u.pn = L & 3; return true;
    }
    __device__ __forceinline__ void a_ready(const pg8::Unit&) const {}
    __device__ __forceinline__ void done(const pg8::Unit&) const {}
};

struct Args { const float* in[20]; float* out; unsigned char* ws; int ph_lo, ph_hi; };

template <int MASK>
__global__ void __launch_bounds__(NWAVES * 64, 2) hymba_fwd(Args args) {
    extern __shared__ __attribute__((aligned(16))) unsigned char lds_raw[];
    LAS unsigned char* lds = (LAS unsigned char*)lds_raw;
    cg::grid_group grid = cg::this_grid();
    if (threadIdx.x < 2) ((volatile LAS unsigned*)(lds + 131072))[threadIdx.x] = 0u;
    __syncthreads();
    const XcdBarrier bar = xcd_barrier_post((unsigned*)(*(unsigned char* const __attribute__((address_space(4)))*)((__attribute__((address_space(4))) const unsigned char*)__builtin_amdgcn_kernarg_segment_ptr() + 168)), (volatile LAS unsigned*)(lds + 131072));
    const int tid = threadIdx.x, lane = tid & 63, wave = __builtin_amdgcn_readfirstlane(tid >> 6);
    const int G = gridDim.x, bx = blockIdx.x, gw = bx * NWAVES + wave, NGW = G * NWAVES;
    typedef __attribute__((address_space(4))) const unsigned char* kptr_t;
    const kptr_t kbase = (kptr_t)__builtin_amdgcn_kernarg_segment_ptr();
#define LDP(T, off) (*(T const volatile __attribute__((address_space(4)))*)(kbase + (off)))
#define P_IN(i) LDP(const float*, 8 * (i))
#define DECL_WS unsigned char* const ws = LDP(unsigned char*, 168); float* const out = LDP(float*, 160); (void)out; (void)ws;
#define xp P_IN(0)
#define xs P_IN(1)
#define ck P_IN(2)
#define cv P_IN(3)
#define pp P_IN(4)
#define ps P_IN(5)
#define n1g P_IN(6)
#define w_in P_IN(7)
#define lng P_IN(8)
#define lnb P_IN(9)
#define wsp P_IN(10)
#define bsp P_IN(11)
#define w_out P_IN(12)
#define n2g P_IN(13)
#define w_up P_IN(14)
#define w_down P_IN(15)
#define gng P_IN(16)
#define w_gate P_IN(17)
#define w_ple P_IN(18)
#define fg P_IN(19)
#define WIN ((bf16_t*)(ws + WS_WIN))
#define WOUT ((bf16_t*)(ws + WS_WOUT))
#define WUP ((bf16_t*)(ws + WS_WUP))
#define WDOWN ((bf16_t*)(ws + WS_WDOWN))
#define WGATE ((bf16_t*)(ws + WS_WGATE))
#define WPLE ((bf16_t*)(ws + WS_WPLE))
#define WSB ((bf16_t*)(ws + WS_WSB))
#define ROPE ((float*)(ws + WS_ROPE))
#define QS ((float*)(ws + WS_SMALL))
#define KS (QS + NSAMP * 512)
#define VS (QS + 2 * NSAMP * 512)
#define US (QS + 3 * NSAMP * 512)
#define VCS (QS + 4 * NSAMP * 512)
#define SSQS1 (QS + 5 * NSAMP * 512)
#define SSQS2 (SSQS1 + NSAMP * 64)
#define SSQS3 (SSQS1 + 2 * NSAMP * 64)
#define SSQ1 ((float*)(ws + WS_SSQ))
#define SSQ2 (SSQ1 + SEQ * 16)
#define SSQ3 (SSQ1 + 2 * SEQ * 16)
#define LSE ((float*)(ws + WS_LSE))
#define OUS ((float*)(ws + WS_H1))
#define LSES (OUS + 6 * NSAMP * 512)
#define PB ((bf16_t*)(ws + WS_PB))
#define ACT ((bf16_t*)(ws + WS_ACT))
#define PLEB ((bf16_t*)(ws + WS_PLEB))
#define MIX ((bf16_t*)(ws + WS_MIX))
#define H1 ((float*)(ws + WS_H1))
#define Qb ((bf16_t*)(ws + WS_BIG))
#define Kb (Qb + (size_t)SEQ * 512)
#define Vb (Qb + (size_t)2 * SEQ * 512)
#define Ub (Qb + (size_t)3 * SEQ * 512)
#define VCb (Qb + (size_t)4 * SEQ * 512)
#define OU (Qb + (size_t)5 * SEQ * 512)
#define HID ((bf16_t*)(ws + WS_BIG))
    const int lo = args.ph_lo, hi = args.ph_hi;
#define IN(k) ((((MASK) >> (k)) & 1) && lo <= (k) && (k) < hi)
#define SEAM(k) do { if (IN(k) && IN((k) + 1)) xcd_barrier(bar); } while (0)
    if (lo > 1000) grid.sync();

    if (IN(0)) { DECL_WS
        LAS float* scr = (LAS float*)(lds + wave * 16384);
        constexpr int I_IN = 16 * 80, I_OUT = 16 * 32, I_UP = 16 * 128, I_DOWN = 64 * 32, I_GATE = 16 * 32, I_PLE = 4 * 32, NITEMS = I_IN + I_OUT + I_UP + I_DOWN + I_GATE + I_PLE;
        { const float* const w_in_ = w_in; const float* const w_out_ = w_out; const float* const w_up_ = w_up; const float* const w_down_ = w_down; const float* const w_gate_ = w_gate; const float* const w_ple_ = w_ple;
          const float* const n2g_ = n2g; const float* const gng_ = gng;
          auto mk = [&](int it) { TrItem t; int r = it;
              if (r < I_IN) { t.W = w_in_; t.WT = WIN; t.gain = nullptr; t.K = DM; t.N = INW; }
              else if ((r -= I_IN) < I_OUT) { t.W = w_out_; t.WT = WOUT; t.gain = nullptr; t.K = DM; t.N = DM; }
              else if ((r -= I_OUT) < I_UP) { t.W = w_up_; t.WT = WUP; t.gain = n2g_; t.K = DM; t.N = DFF; }
              else if ((r -= I_UP) < I_DOWN) { t.W = w_down_; t.WT = WDOWN; t.gain = nullptr; t.K = DFF; t.N = DM; }
              else if ((r -= I_DOWN) < I_GATE) { t.W = w_gate_; t.WT = WGATE; t.gain = gng_; t.K = DM; t.N = DM; }
              else { r -= I_GATE; t.W = w_ple_; t.WT = WPLE; t.gain = nullptr; t.K = PLE; t.N = DM; }
              const int nblk = t.N / 32; t.k0 = 64 * (r / nblk); t.n0 = 32 * (r % nblk); return t; };
          float tva[32], tvb[32];
          int it = gw;
          if (it < NITEMS) { TrItem ca = mk(it); p0_tr_load(ca, tva, lane);
              for (;;) {
                  const int itb = it + NGW; const bool hb = itb < NITEMS; TrItem cb = ca; if (hb) { cb = mk(itb); p0_tr_load(cb, tvb, lane); }
                  p0_tr_store(ca, tva, scr, lane);
                  if (!hb) break;
                  const int itc = itb + NGW; const bool hc = itc < NITEMS; if (hc) { ca = mk(itc); p0_tr_load(ca, tva, lane); }
                  p0_tr_store(cb, tvb, scr, lane);
                  if (!hc) break;
                  it = itc;
              } }
        }
        { const float* const xp_ = xp; const float* const xs_ = xs; const float* const pp_ = pp; const float* const ps_ = ps; const float* const n1g_ = n1g;
          f32x4 gg[4];
#pragma unroll
          for (int j = 0; j < 4; ++j) gg[j] = ((const f32x4*)n1g_)[64 * j + lane];
          for (int m0 = gw; m0 < MTOT; m0 += 8 * NGW) {
            f32x4 v[8][4]; f32x4 pv[8]; float ssq[8];
#pragma unroll
            for (int r = 0; r < 8; ++r) { const int m = m0 + r * NGW; const bool ok = m < MTOT; const int mm = ok ? m : 0;
                const float* src = mm < SEQ ? xp_ + (size_t)mm * DM : xs_ + (size_t)(mm - SEQ) * DM;
                const float* psrc = mm < SEQ ? pp_ + (size_t)mm * PLE : ps_ + (size_t)(mm - SEQ) * PLE;
#pragma unroll
                for (int j = 0; j < 4; ++j) v[r][j] = __builtin_nontemporal_load((const f32x4*)src + 64 * j + lane);
                pv[r] = __builtin_nontemporal_load((const f32x4*)psrc + lane); }
#pragma unroll
            for (int r = 0; r < 8; ++r) { float sacc = 0.f;
#pragma unroll
                for (int j = 0; j < 4; ++j) sacc += (v[r][j][0] * v[r][j][0] + v[r][j][1] * v[r][j][1]) + (v[r][j][2] * v[r][j][2] + v[r][j][3] * v[r][j][3]);
                ssq[r] = sacc; }
#pragma unroll
            for (int o = 1; o < 64; o <<= 1) {
#pragma unroll
                for (int r = 0; r < 8; ++r) ssq[r] += __shfl_xor(ssq[r], o); }
#pragma unroll
            for (int r = 0; r < 8; ++r) { const int m = m0 + r * NGW; if (m < MTOT) { const float rstd = 1.0f / sqrtf(ssq[r] * (1.0f / DM) + EPS);
#pragma unroll
                for (int j = 0; j < 4; ++j) *(u32x2*)(ACT + (size_t)m * DM + 256 * j + 4 * lane) = pack4(v[r][j] * rstd * gg[j]);
                *(u32x2*)(PB + (size_t)m * PLE + 4 * lane) = pack4(pv[r]); } }
          } }
        for (int idx = bx * 512 + tid; idx < (SEQ + 4) * 8; idx += G * 512) {
            const int pos = idx >> 3, i = idx & 7;
            const float invf = i == 0 ? 1.0f : i == 1 ? 0.1939227432012558f : i == 2 ? 0.03760603070259094f : i == 3 ? 0.007292664609849453f : i == 4 ? 0.0014142135623842478f : i == 5 ? 0.00027424818836152554f : i == 6 ? 5.3182957344688475e-05f : 1.0313385246263351e-05f;
            const float ang = (float)pos * invf; float s, c; sincos_d((double)ang, s, c);
            ROPE[(size_t)pos * 16 + i] = c; ROPE[(size_t)pos * 16 + 8 + i] = s;
        }
        for (int idx = bx * 512 + tid; idx < 8 * 128 * 128; idx += G * 512) { const int i = (idx >> 7) & 127, j = idx & 127; WSB[idx] = (bf16_t)f2bf(j <= i ? wsp[idx] : 0.f); }
    }
    SEAM(0);
    if (IN(1)) { DECL_WS
        { pg8::Gemm g{ACT, WIN, SEQ, INW, DM}; pg8::StaticOrder S; S.init(SEQ, INW, G, bx);
          pg8::EpiIn E{Qb, Kb, Vb, Ub, VCb, ROPE, out + OUT_KP, out + OUT_VP};
          pg8::gemm_phase<pg8::EpiIn, pg8::StaticOrder, true, true>(lds, g, S, E); }
        { int kple = PLE; asm volatile("" : "+s"(kple));
          pg8::Gemm g{PB, WPLE, SEQ, DM, kple}; PleOrder S{bx, G}; pg8::EpiBf E{PLEB};
          pg8::gemm_phase<pg8::EpiBf, PleOrder, true, true>(lds, g, S, E); }
        float* oks = out + OUT_KS; float* ovs = out + OUT_VS;
        const int sG = (G == 256) ? 64 : G, sbx = (G == 256) ? (bx >= 192 ? bx - 192 : 1 << 20) : bx;
        small_gemm_w64<4>(lds, ACT + (size_t)SEQ * DM, WIN, DM, INW, bx, G, wave, lane, [=](int rb, int col, int nt, f32x4 acc) {
            const int seg = col >> 9, lc = col & 511, fr = col & 15; const bool rp = seg < 2 && (nt & 3) == 0;
#pragma unroll
            for (int i = 0; i < 4; ++i) { const int row = rb + i; float v = acc[i];
                if (rp) { const float p = __shfl_xor(v, 8); const float* r = ROPE + (size_t)(SEQ + (row & 3)) * 16 + (fr & 7); const float c = r[0], s = r[8]; v = fr < 8 ? v * c - p * s : v * c + p * s; }
                const size_t o = (size_t)row * 512 + lc;
                if (seg == 0) QS[o] = v * QSCALE; else if (seg == 1) { KS[o] = v; oks[o] = v; } else if (seg == 2) { VS[o] = v; ovs[o] = v; } else if (seg == 3) US[o] = pg8::gelu_tanh(v); else VCS[o] = pg8::gelu_tanh(v); } });
        small_gemm<1>(lds, PB + (size_t)SEQ * PLE, WPLE, PLE, DM, sbx, sG, wave, lane, [=](int rb, int col, int nt, f32x4 acc) {
#pragma unroll
            for (int i = 0; i < 4; ++i) PLEB[(size_t)(SEQ + rb + i) * DM + col] = (bf16_t)f2bf(acc[i]); });
    }
    SEAM(1);
    if (IN(2)) { DECL_WS
        const bool mem_first = (bx & 8) != 0;
        if (mem_first) {
            for (int t = gw; t < 6144 + 32; t += NGW) { if (t < 6144) samp_attn_task(t, lane, QS, KS, VS, ck, cv, OUS, LSES); else samp_gmlp_task(t - 6144, lane, VCS, US, lng, lnb, wsp, bsp, out + OUT_VC, MIX); }
            for (int c = bx; c < 256; c += G) gmlp_unit(lds, c, VCb, Ub, lng, lnb, WSB, bsp, MIX);
        }
        { AttnPre P; if (bx < 3 * 64 * 8) attn_prefetch(P, bx, Kb, Vb);
          for (int a = bx; a < 3 * 64 * 8; a += G) attn_unit(lds, a, a + G, a + G < 3 * 64 * 8, P, Qb, Kb, Vb, OU, LSE); }
        if (!mem_first) {
            for (int c = bx; c < 256; c += G) gmlp_unit(lds, c, VCb, Ub, lng, lnb, WSB, bsp, MIX);
            for (int t = gw; t < 6144 + 32; t += NGW) { if (t < 6144) samp_attn_task(t, lane, QS, KS, VS, ck, cv, OUS, LSES); else samp_gmlp_task(t - 6144, lane, VCS, US, lng, lnb, wsp, bsp, out + OUT_VC, MIX); }
        }
    }
    SEAM(2);
    if (IN(3)) { DECL_WS
        for (int idx = bx * 512 + tid; idx < SEQ * 64; idx += G * 512) {
            const int tok = idx >> 6, hd = (idx >> 3) & 7, chk = idx & 7;
            const float l0 = LSE[(size_t)tok * 8 + hd], l1 = LSE[((size_t)SEQ + tok) * 8 + hd], l2 = LSE[((size_t)2 * SEQ + tok) * 8 + hd];
            const float mx = fmaxf(l0, fmaxf(l1, l2)); float w0 = __builtin_amdgcn_exp2f(l0 - mx), w1 = __builtin_amdgcn_exp2f(l1 - mx), w2 = __builtin_amdgcn_exp2f(l2 - mx);
            const float rw = 1.0f / (w0 + w1 + w2); w0 *= rw; w1 *= rw; w2 *= rw;
            const size_t o = (size_t)tok * 512 + hd * 64 + chk * 8;
            const u32x4 a = *(const u32x4*)(OU + o), b = *(const u32x4*)(OU + (size_t)SEQ * 512 + o), c = *(const u32x4*)(OU + (size_t)2 * SEQ * 512 + o);
            u32x4 r;
#pragma unroll
            for (int e = 0; e < 4; ++e) { const float lo_ = __uint_as_float(a[e] << 16) * w0 + __uint_as_float(b[e] << 16) * w1 + __uint_as_float(c[e] << 16) * w2;
                const float hi_ = __uint_as_float(a[e] & 0xffff0000u) * w0 + __uint_as_float(b[e] & 0xffff0000u) * w1 + __uint_as_float(c[e] & 0xffff0000u) * w2; r[e] = cvt_pk_bf16(lo_, hi_); }
            *(u32x4*)(MIX + (size_t)tok * 1024 + hd * 64 + chk * 8) = r;
        }
        for (int idx = bx * 512 + tid; idx < NSAMP * 64; idx += G * 512) {
            const int tok = idx >> 6, hd = (idx >> 3) & 7, chk = idx & 7;
            float l[6], mx = -1e30f;
#pragma unroll
            for (int p = 0; p < 6; ++p) { l[p] = LSES[((size_t)p * NSAMP + tok) * 8 + hd]; mx = fmaxf(mx, l[p]); }
            float wsum = 0.f;
#pragma unroll
            for (int p = 0; p < 6; ++p) { l[p] = __builtin_amdgcn_exp2f(l[p] - mx); wsum += l[p]; }
            const float rw = 1.0f / wsum; const size_t o = (size_t)tok * 512 + hd * 64 + chk * 8;
            f32x4 a0 = {0.f, 0.f, 0.f, 0.f}, a1 = a0;
#pragma unroll
            for (int p = 0; p < 6; ++p) { const float w = l[p] * rw; a0 = a0 + *(const f32x4*)(OUS + (size_t)p * NSAMP * 512 + o) * w; a1 = a1 + *(const f32x4*)(OUS + (size_t)p * NSAMP * 512 + o + 4) * w; }
            *(u32x4*)(MIX + (size_t)(SEQ + tok) * 1024 + hd * 64 + chk * 8) = pack8(a0, a1);
        }
    }
    SEAM(3);
    if (IN(4)) { DECL_WS
        { pg8::Gemm g{MIX, WOUT, SEQ, DM, DM}; pg8::StaticOrder S; S.init(SEQ, DM, G, bx); pg8::EpiRes<true> E{xp, ACT, SSQ1};
          pg8::gemm_phase<pg8::EpiRes<true>, pg8::StaticOrder, false, true>(lds, g, S, E); }
        small_gemm<4>(lds, MIX + (size_t)SEQ * DM, WOUT, DM, DM, bx, G, wave, lane, [=](int rb, int col, int nt, f32x4 acc) {
#pragma unroll
            for (int i = 0; i < 4; ++i) { const int row = rb + i; const bf16_t hb = (bf16_t)f2bf(xs[(size_t)row * DM + col] + acc[i]); const float h = pg8::bf2f(hb); ACT[(size_t)(SEQ + row) * DM + col] = hb;
                const float s = red16(h * h); if ((col & 15) == 0) SSQS1[row * 64 + nt] = s; } });
    }
    SEAM(4);
    if (IN(5)) { DECL_WS
        { pg8::Gemm g{ACT, WUP, SEQ, DFF, DM}; pg8::StaticOrder S; S.init(SEQ, DFF, G, bx); pg8::EpiUp E{HID, SSQ1};
          pg8::gemm_phase<pg8::EpiUp, pg8::StaticOrder, true, true>(lds, g, S, E); }
        small_gemm_w64<4>(lds, ACT + (size_t)SEQ * DM, WUP, DM, DFF, bx, G, wave, lane, [=](int rb, int col, int nt, f32x4 acc) {
#pragma unroll
            for (int i = 0; i < 4; ++i) { const int row = rb + i; const float rs = rstd_from_slots64(SSQS1 + row * 64, col & 15); float v = fmaxf(acc[i] * rs, 0.f); HID[(size_t)(SEQ + row) * DFF + col] = (bf16_t)f2bf(v * v); } });
    }
    SEAM(5);
    if (IN(6)) { DECL_WS
        { pg8::Gemm g{HID, WDOWN, SEQ, DM, DFF}; pg8::StaticOrder S; S.init(SEQ, DM, G, bx); pg8::EpiRes<false> E{ACT, ACT, SSQ2};
          pg8::gemm_phase<pg8::EpiRes<false>, pg8::StaticOrder, false, true>(lds, g, S, E); }
        small_gemm<4>(lds, HID + (size_t)SEQ * DFF, WDOWN, DFF, DM, bx, G, wave, lane, [=](int rb, int col, int nt, f32x4 acc) {
#pragma unroll
            for (int i = 0; i < 4; ++i) { const int row = rb + i; const bf16_t hb = (bf16_t)f2bf(pg8::bf2f(ACT[(size_t)(SEQ + row) * DM + col]) + acc[i]); const float h = pg8::bf2f(hb); ACT[(size_t)(SEQ + row) * DM + col] = hb;
                const float s = red16(h * h); if ((col & 15) == 0) SSQS2[row * 64 + nt] = s; } });
    }
    SEAM(6);
    if (IN(7)) { DECL_WS
        { pg8::Gemm g{ACT, WGATE, SEQ, DM, DM}; pg8::StaticOrder S; S.init(SEQ, DM, G, bx); pg8::EpiGateFinal E{ACT, PLEB, SSQ2, fg, out, SSQ3, (unsigned*)ws + 4096};
          pg8::gemm_phase<pg8::EpiGateFinal, pg8::StaticOrder, false, true>(lds, g, S, E); }
        unsigned* cnts = (unsigned*)ws + 4096 + 64 * 64;
        small_gemm<4>(lds, ACT + (size_t)SEQ * DM, WGATE, DM, DM, bx, G, wave, lane, [=](int rb, int col, int nt, f32x4 acc) {
            float y[4];
#pragma unroll
            for (int i = 0; i < 4; ++i) { const int row = rb + i; const size_t o = (size_t)(SEQ + row) * DM + col; const float rs = rstd_from_slots64(SSQS2 + row * 64, col & 15);
                const float gt = __builtin_amdgcn_rcpf(1.0f + __builtin_amdgcn_exp2f(-1.4426950408889634f * acc[i] * rs)); y[i] = pg8::bf2f(ACT[o]) + gt * pg8::bf2f(PLEB[o]);
                const float s = red16(y[i] * y[i]); if ((col & 15) == 0) __hip_atomic_store(SSQS3 + row * 64 + nt, s, __ATOMIC_RELAXED, __HIP_MEMORY_SCOPE_AGENT); }
            const int mt = rb >> 4;
            asm volatile("s_waitcnt vmcnt(0)" ::: "memory");
            if ((col & 15) == 0 && (rb & 15) == 0) __hip_atomic_fetch_add(cnts + 64 * mt, 1u, __ATOMIC_RELAXED, __HIP_MEMORY_SCOPE_AGENT);
            { unsigned spins = 0; while ((unsigned)__builtin_amdgcn_readfirstlane(__hip_atomic_load(cnts + 64 * mt, __ATOMIC_RELAXED, __HIP_MEMORY_SCOPE_AGENT)) < 64u && ++spins < (1u << 22)) __builtin_amdgcn_s_sleep(2); }
            __builtin_amdgcn_fence(__ATOMIC_ACQUIRE, "agent");
            const float gcol = fg[col];
#pragma unroll
            for (int i = 0; i < 4; ++i) { const int row = rb + i; const float* sp = SSQS3 + row * 64 + 4 * (col & 15);
                const float t = (__hip_atomic_load(sp, __ATOMIC_RELAXED, __HIP_MEMORY_SCOPE_AGENT) + __hip_atomic_load(sp + 1, __ATOMIC_RELAXED, __HIP_MEMORY_SCOPE_AGENT)) + (__hip_atomic_load(sp + 2, __ATOMIC_RELAXED, __HIP_MEMORY_SCOPE_AGENT) + __hip_atomic_load(sp + 3, __ATOMIC_RELAXED, __HIP_MEMORY_SCOPE_AGENT));
                out[(size_t)(SEQ + row) * DM + col] = y[i] * (1.0f / sqrtf(red16(t) * (1.0f / 1024.0f) + EPS)) * gcol; }
            });
    }
#undef IN
#undef SEAM
}

extern "C" void kernel_launch(void* const* d_in, const int* in_sizes, int n_in, void* d_out, int out_size, void* d_ws, size_t ws_size, hipStream_t stream) {
    static int grid = 0;
    if (grid == 0) {
        if (n_in != 20 || out_size != (int)OUT_END || ws_size < WS_END) { fprintf(stderr, "kernel_launch: unexpected shapes: n_in %d out %d ws %zu\n", n_in, out_size, ws_size); grid = -1; return; }
        int dev = 0, cus = 0, per_cu = 0;
        (void)hipGetDevice(&dev); (void)hipDeviceGetAttribute(&cus, hipDeviceAttributeMultiprocessorCount, dev);
#if MK_ONE_LAUNCH
        if (hipFuncSetAttribute((const void*)hymba_fwd<MK_MASK>, hipFuncAttributeMaxDynamicSharedMemorySize, LDS_BYTES) != hipSuccess) { fprintf(stderr, "kernel_launch: hipFuncSetAttribute failed\n"); grid = -1; return; }
        if (hipOccupancyMaxActiveBlocksPerMultiprocessor(&per_cu, (const void*)hymba_fwd<MK_MASK>, NWAVES * 64, LDS_BYTES) != hipSuccess || per_cu < 1) { fprintf(stderr, "kernel_launch: occupancy query says %d\n", per_cu); per_cu = 1; }
        (void)hipGetLastError();
#else
        (void)per_cu;
#endif
        grid = cus * 1;
        if (grid <= 0) grid = 256;
    }
    if (grid < 0) return;
    (void)hipMemsetAsync(d_ws, 0, 65536, stream);
    Args a{};
    for (int i = 0; i < 20; ++i) a.in[i] = (const float*)d_in[i];
    a.out = (float*)d_out; a.ws = (unsigned char*)d_ws;
#if MK_ONE_LAUNCH
    a.ph_lo = 0; a.ph_hi = NPH;
    void* kargs[] = {&a};
    hipError_t e = hipLaunchCooperativeKernel((const void*)hymba_fwd<MK_MASK>, dim3(grid), dim3(NWAVES * 64), kargs, LDS_BYTES, stream);
    if (e != hipSuccess) fprintf(stderr, "kernel_launch: cooperative launch failed: %s (grid %d)\n", hipGetErrorString(e), grid);
#else
#define LAUNCH_PH(p) do { a.ph_lo = p; a.ph_hi = p + 1; (void)hipFuncSetAttribute((const void*)hymba_fwd<(1 << p)>, hipFuncAttributeMaxDynamicSharedMemorySize, LDS_BYTES); hipLaunchKernelGGL(hymba_fwd<(1 << p)>, dim3(grid), dim3(NWAVES * 64), LDS_BYTES, stream, a); } while (0)
    LAUNCH_PH(0); LAUNCH_PH(1); LAUNCH_PH(2); LAUNCH_PH(3); LAUNCH_PH(4); LAUNCH_PH(5); LAUNCH_PH(6); LAUNCH_PH(7); LAUNCH_PH(8);
#endif
}
```
